# Optimizing an MI355X kernel written in HIP

```python
import math
import jax, jax.numpy as jnp
from jax import lax
import numpy as np

D_MODEL = 1024
BATCH = 2
SEQ = 8192
DEPTH = 1
DEC_BATCH = 128
DEC_SEQ = 1
PAST_LEN = 2048
PAGE_SIZE = 128

MIX_WIDTH = D_MODEL
R_WIDTH = MIX_WIDTH // 2
A_WIDTH = MIX_WIDTH - R_WIDTH
R_EXPAND = 128
R_HEADS = R_WIDTH // R_EXPAND
R_DK = R_EXPAND
R_DV = R_WIDTH // R_HEADS
A_HEADS = 4
A_DV = A_WIDTH // A_HEADS
A_DK = A_DV // 2
D_FF = -(-8 * D_MODEL // (3 * 256)) * 256
CHUNK = 64
Q_BLOCK = 128
EPS = 1e-6
PROJ_SIZES = (R_HEADS * R_DK, R_HEADS * R_DK, R_WIDTH, R_WIDTH,
              2 * A_HEADS * A_DK, 2 * A_HEADS * A_DK, A_WIDTH)
D_IN = sum(PROJ_SIZES)

kernel_name = "hymba_hgrn2_diffattn_decode_step"


def rmsnorm(x, g):
    xf = x.astype(jnp.float32)
    y = xf * lax.rsqrt(jnp.mean(xf * xf, axis=-1, keepdims=True) + EPS)
    return (y * g.astype(jnp.float32)).astype(x.dtype)


def project(h, w_in_l, lb_l):
    B, T, _ = h.shape
    p = jnp.einsum('btd,de->bte', h, w_in_l)
    offs = np.cumsum(PROJ_SIZES)[:-1].tolist()
    rq, rf, ri, rg, aq, ak, av = jnp.split(p, offs, axis=-1)
    f = lb_l + (1.0 - lb_l) * jax.nn.sigmoid(rf.astype(jnp.float32))
    logf = jnp.log(f).reshape(B, T, R_HEADS, R_DK)
    rk = (1.0 - f).reshape(B, T, R_HEADS, R_DK)
    rq = jax.nn.silu(rq.astype(jnp.float32)).reshape(B, T, R_HEADS, R_DK)
    rv = ri.astype(jnp.float32).reshape(B, T, R_HEADS, R_DV)
    aq = aq.reshape(B, T, A_HEADS, 2, A_DK)
    ak = ak.reshape(B, T, A_HEADS, 2, A_DK)
    av = av.reshape(B, T, A_HEADS, A_DV)
    return rq, rk, rv, logf, rg, aq, ak, av


def hgrn_chunked(q, k, v, logf, s0):
    B, T, H, DK = q.shape
    DV = v.shape[-1]
    n = T // CHUNK

    def to_chunks(a):
        return a.reshape(B, n, CHUNK, H, a.shape[-1]).transpose(1, 0, 3, 2, 4)

    causal = jnp.tril(jnp.ones((CHUNK, CHUNK), dtype=bool))[:, :, None]

    def step(S, blk):
        qb, kb, vb, gb = blk
        b = jnp.cumsum(gb, axis=2)
        o_inter = jnp.einsum('bhtk,bhkv->bhtv', qb * jnp.exp(b), S)
        rel = b[:, :, :, None, :] - b[:, :, None, :, :]
        decay = jnp.exp(jnp.where(causal, rel, -jnp.inf))
        A = jnp.einsum('bhtk,bhsk,bhtsk->bhts', qb, kb, decay)
        o = o_inter + jnp.einsum('bhts,bhsv->bhtv', A, vb)
        b_last = b[:, :, -1:, :]
        S_new = jnp.exp(b_last[:, :, 0, :])[..., None] * S + jnp.einsum(
            'bhsk,bhsv->bhkv', kb * jnp.exp(b_last - b), vb)
        return S_new, o

    S_fin, o = lax.scan(step, s0, (to_chunks(q), to_chunks(k), to_chunks(v), to_chunks(logf)))
    o = o.transpose(1, 0, 3, 2, 4).reshape(B, T, H, DV)
    return o, S_fin


def hgrn_recurrent(q, k, v, logf, s0):
    def step(S, xs):
        qt, kt, vt, gt = xs
        S = jnp.exp(gt)[..., None] * S + kt[..., None] * vt[..., None, :]
        return S, jnp.einsum('bhk,bhkv->bhv', qt, S)

    S_fin, o = lax.scan(step, s0, (q.swapaxes(0, 1), k.swapaxes(0, 1),
                                   v.swapaxes(0, 1), logf.swapaxes(0, 1)))
    return o.swapaxes(0, 1), S_fin


def diff_attend(q, k, v, q_pos, lam, lam_init, subln_l):
    s = jnp.einsum('bqhmd,bkhmd->bhmqk', q.astype(jnp.float32), k.astype(jnp.float32)) * (A_DK ** -0.5)
    mask = jnp.arange(k.shape[1])[None, :] <= q_pos[:, None]
    p = jax.nn.softmax(jnp.where(mask, s, -jnp.inf), axis=-1)
    attn = p[:, :, 0] - lam * p[:, :, 1]
    o = jnp.einsum('bhqk,bkhv->bqhv', attn, v.astype(jnp.float32))
    return rmsnorm(o, subln_l) * (1.0 - lam_init)


def diff_prompt(aq, ak, av, lam, lam_init, subln_l):
    B, T = aq.shape[:2]
    nb = T // Q_BLOCK
    qb = aq.reshape(B, nb, Q_BLOCK, A_HEADS, 2, A_DK).transpose(1, 0, 2, 3, 4, 5)
    pos = jnp.arange(T).reshape(nb, Q_BLOCK)
    o = lax.map(lambda a: diff_attend(a[0], ak, av, a[1], lam, lam_init, subln_l), (qb, pos))
    return o.transpose(1, 0, 2, 3, 4).reshape(B, T, A_HEADS, A_DV)


def diff_sample(aq, ak, av, cache_k_l, cache_v_l, page_table, lam, lam_init, subln_l):
    DB, T = aq.shape[:2]
    past = page_table.shape[1] * PAGE_SIZE
    k_past = cache_k_l[page_table].reshape(DB, past, A_HEADS, 2, A_DK)
    v_past = cache_v_l[page_table].reshape(DB, past, A_HEADS, A_DV)
    k = jnp.concatenate([k_past.astype(ak.dtype), ak], axis=1)
    v = jnp.concatenate([v_past.astype(av.dtype), av], axis=1)
    q_pos = past + jnp.arange(T)
    return diff_attend(aq, k, v, q_pos, lam, lam_init, subln_l)


def merge(o_r, g, o_a, r_gnorm_l, w_out_l, dtype):
    B, T = o_r.shape[:2]
    o_r = rmsnorm(o_r, r_gnorm_l) * jax.nn.silu(g.astype(jnp.float32)).reshape(B, T, R_HEADS, R_DV)
    o = jnp.concatenate([o_r.reshape(B, T, R_WIDTH), o_a.reshape(B, T, A_WIDTH)], axis=-1).astype(dtype)
    return jnp.einsum('bte,ed->btd', o, w_out_l)


def swiglu(h, wg, wu, wd):
    return jnp.einsum('btf,fd->btd', jax.nn.silu(jnp.einsum('btd,df->btf', h, wg)) * jnp.einsum('btd,df->btf', h, wu), wd)


def setup_inputs(seed: int = 0) -> dict:
    key = jax.random.key(seed)
    ks = jax.random.split(key, 24)
    n_pages = PAST_LEN // PAGE_SIZE
    n_phys = (DEC_BATCH * n_pages * 5) // 4
    f32 = jnp.float32
    nrm = lambda k, shape, s: jax.random.normal(k, shape, f32) * s
    x_prompt = nrm(ks[0], (BATCH, SEQ, D_MODEL), 1.0)
    x_sample = nrm(ks[1], (DEC_BATCH, DEC_SEQ, D_MODEL), 1.0)
    cache_k = nrm(ks[2], (DEPTH, n_phys, PAGE_SIZE, A_HEADS, 2, A_DK), 1.0)
    cache_v = nrm(ks[3], (DEPTH, n_phys, PAGE_SIZE, A_HEADS, A_DV), 1.0)
    state_hgrn = nrm(ks[4], (DEPTH, DEC_BATCH, R_HEADS, R_DK, R_DV), 0.5)
    page_table = jax.random.permutation(ks[5], n_phys)[:DEC_BATCH * n_pages].reshape(DEC_BATCH, n_pages).astype(jnp.int32)
    return {
        "x_prompt": x_prompt,
        "x_sample": x_sample,
        "cache_k": cache_k,
        "cache_v": cache_v,
        "state_hgrn": state_hgrn,
        "page_table": page_table,
        "w_in": nrm(ks[6], (DEPTH, D_MODEL, D_IN), D_MODEL ** -0.5),
        "w_out": nrm(ks[7], (DEPTH, MIX_WIDTH, D_MODEL), MIX_WIDTH ** -0.5),
        "lb_param": nrm(ks[8], (DEPTH + 1, R_HEADS * R_DK), 0.1),
        "r_gnorm": 1.0 + nrm(ks[9], (DEPTH, R_DV), 0.02),
        "lam_q1": nrm(ks[10], (DEPTH, A_DK), 0.1),
        "lam_k1": nrm(ks[11], (DEPTH, A_DK), 0.1),
        "lam_q2": nrm(ks[12], (DEPTH, A_DK), 0.1),
        "lam_k2": nrm(ks[13], (DEPTH, A_DK), 0.1),
        "a_subln": 1.0 + nrm(ks[14], (DEPTH, A_DV), 0.02),
        "norm_mix": 1.0 + nrm(ks[15], (DEPTH, D_MODEL), 0.02),
        "norm_ffn": 1.0 + nrm(ks[16], (DEPTH, D_MODEL), 0.02),
        "w_gate": nrm(ks[17], (DEPTH, D_MODEL, D_FF), D_MODEL ** -0.5),
        "w_up": nrm(ks[18], (DEPTH, D_MODEL, D_FF), D_MODEL ** -0.5),
        "w_down": nrm(ks[19], (DEPTH, D_FF, D_MODEL), D_FF ** -0.5),
        "norm_final": 1.0 + nrm(ks[20], (D_MODEL,), 0.02),
    }


def reference(x_prompt, x_sample, cache_k, cache_v, state_hgrn, page_table, w_in, w_out, lb_param,
              r_gnorm, lam_q1, lam_k1, lam_q2, lam_k2, a_subln, norm_mix, norm_ffn, w_gate, w_up,
              w_down, norm_final):
    hp, hs = x_prompt, x_sample
    B = x_prompt.shape[0]
    lb_all = jnp.cumsum(jax.nn.softmax(lb_param.astype(jnp.float32), axis=0), axis=0)
    kp, vp, sp, kss, vss, sss = [], [], [], [], [], []
    for l in range(DEPTH):
        lam_init = 0.8 - 0.6 * math.exp(-0.3 * l)
        lam = (jnp.exp(jnp.sum(lam_q1[l].astype(jnp.float32) * lam_k1[l].astype(jnp.float32)))
               - jnp.exp(jnp.sum(lam_q2[l].astype(jnp.float32) * lam_k2[l].astype(jnp.float32))) + lam_init)
        rq, rk, rv, logf, rg, aq, ak, av = project(rmsnorm(hp, norm_mix[l]), w_in[l], lb_all[l])
        s0 = jnp.zeros((B, R_HEADS, R_DK, R_DV), jnp.float32)
        o_r, s_new = hgrn_chunked(rq, rk, rv, logf, s0)
        o_a = diff_prompt(aq, ak, av, lam, lam_init, a_subln[l])
        hp = hp + merge(o_r, rg, o_a, r_gnorm[l], w_out[l], hp.dtype)
        hp = hp + swiglu(rmsnorm(hp, norm_ffn[l]), w_gate[l], w_up[l], w_down[l])
        kp.append(ak); vp.append(av); sp.append(s_new)
        rq, rk, rv, logf, rg, aq, ak, av = project(rmsnorm(hs, norm_mix[l]), w_in[l], lb_all[l])
        o_r, s_new = hgrn_recurrent(rq, rk, rv, logf, state_hgrn[l].astype(jnp.float32))
        o_a = diff_sample(aq, ak, av, cache_k[l], cache_v[l], page_table, lam, lam_init, a_subln[l])
        hs = hs + merge(o_r, rg, o_a, r_gnorm[l], w_out[l], hs.dtype)
        hs = hs + swiglu(rmsnorm(hs, norm_ffn[l]), w_gate[l], w_up[l], w_down[l])
        kss.append(ak); vss.append(av); sss.append(s_new)
    y_prompt = rmsnorm(hp, norm_final)
    y_sample = rmsnorm(hs, norm_final)
    k_prompt = jnp.stack(kp)
    v_prompt = jnp.stack(vp)
    s_prompt = jnp.stack(sp)
    k_sample = jnp.stack(kss)
    v_sample = jnp.stack(vss)
    s_sample = jnp.stack(sss)
    return (y_prompt, y_sample, k_prompt, v_prompt, s_prompt, k_sample, v_sample, s_sample)
```

```cpp
#include <hip/hip_runtime.h>
#include <hip/hip_bf16.h>
#include <cstdio>
#include <cstdint>

constexpr int DM = 1024, NBATCH = 2, SEQ = 8192, MP = NBATCH * SEQ, MS = 128, MT = MP + MS;
constexpr int DIN = 3584, DFF = 2816, NGU = 2 * DFF;
constexpr int NPAGES = 16, PAGE = 128;
constexpr int CH = 64, NCH = SEQ / CH, NHU = NBATCH * 4 * NCH;
constexpr float EPS = 1e-6f;
constexpr float LOG2E = 1.4426950408889634f, LN2 = 0.6931471805599453f;
constexpr float LAM_INIT = 0.2f;

#define GAS __attribute__((address_space(1)))
#define LAS __attribute__((address_space(3)))
typedef unsigned short bf16;
typedef unsigned v4u __attribute__((ext_vector_type(4)));
typedef unsigned v2u __attribute__((ext_vector_type(2)));
typedef float f32x4 __attribute__((ext_vector_type(4)));
typedef float f32x16 __attribute__((ext_vector_type(16)));
typedef short bf16x8 __attribute__((ext_vector_type(8)));
typedef GAS unsigned gu32;
#define RLX_AGENT __ATOMIC_RELAXED, __HIP_MEMORY_SCOPE_AGENT
#define LDS_WAIT() asm volatile("s_waitcnt lgkmcnt(0)" ::: "memory")
#define VM_WAIT() asm volatile("s_waitcnt vmcnt(0)" ::: "memory")
__device__ __forceinline__ unsigned f2bf(float f) { unsigned u = __builtin_bit_cast(unsigned, f); return (u + 0x7fffu + ((u >> 16) & 1u)) >> 16; }
__device__ __forceinline__ unsigned pk2(float lo, float hi) { return f2bf(lo) | (f2bf(hi) << 16); }
__device__ __forceinline__ float bf2f(unsigned short b) { return __builtin_bit_cast(float, (unsigned)b << 16); }
__device__ __forceinline__ float sigm(float x) { return __builtin_amdgcn_rcpf(1.0f + __builtin_amdgcn_exp2f(-LOG2E * x)); }
__device__ __forceinline__ float siluf(float x) { return x * sigm(x); }
__device__ __forceinline__ float fexp(float x) { return __builtin_amdgcn_exp2f(LOG2E * x); }
__device__ __forceinline__ float wave_sum(float v) {
#pragma unroll
    for (int o = 1; o < 64; o <<= 1) v += __shfl_xor(v, o);
    return v;
}
__device__ __forceinline__ float wave_max(float v) {
#pragma unroll
    for (int o = 1; o < 64; o <<= 1) v = fmaxf(v, __shfl_xor(v, o));
    return v;
}
namespace pg8 {
#define PG8_LAS __attribute__((address_space(3)))
typedef unsigned short bf16_t;
typedef short bf16x8 __attribute__((ext_vector_type(8)));
typedef float f32x4 __attribute__((ext_vector_type(4)));
typedef unsigned u32x4 __attribute__((ext_vector_type(4)));
constexpr int BM = 256, BK = 64, HALF = 128, HTB = HALF * BK * 2  , STAGE_BYTES = 8 * HTB, NXCD = 8, WGM = 8;

__host__ __device__ __forceinline__ int lds_byte(int r, int c) { const int st = (r >> 4) * 2 + (c >> 5), rr = r & 15, cc = c & 31, ob = rr * 64 + cc * 2; return st * 1024 + (ob ^ (((ob >> 9) & 1) << 5)); }
__host__ __device__ __forceinline__ void stage_rc(int b, int& R, int& C) { const int st = b / 1024, sb = b % 1024, swz = sb ^ (((sb >> 9) & 1) << 5); R = (st >> 1) * 16 + swz / 64; C = (st & 1) * 32 + (swz % 64) / 2; }
__host__ __device__ __forceinline__ int perm32(int rho) { const int n = rho >> 4, i = rho & 15; return 8 * (i >> 2) + 4 * n + (i & 3); }

struct Unit { int pm, pn; };
struct Gemm { const bf16_t* A; const bf16_t* Bt; int M, N, K; };

struct StaticOrder {
    int nM, nN, nwg, G, c;
    __host__ __device__ void init(int M, int N, int G_, int c_) { nM = M / BM; nN = N / BM; nwg = nM * nN; G = G_; c = c_; }
    __host__ __device__ bool next(int i, Unit& u) const {
        const long L = (long)i * G + c; if (L >= nwg) return false;
        int wgid = (int)L; { const int q = nwg / NXCD, r = nwg % NXCD, xcd = wgid % NXCD, off = wgid / NXCD; wgid = (xcd < r ? xcd * (q + 1) : r * (q + 1) + (xcd - r) * q) + off; }
        const int nig = WGM * nN, gid = wgid / nig, fm = gid * WGM, gsz = (nM - fm) < WGM ? (nM - fm) : WGM;
        u.pm = fm + ((wgid % nig) % gsz); u.pn = (wgid % nig) / gsz; return true;
    }
    __device__ __forceinline__ void a_ready(const Unit&) const {}
    __device__ __forceinline__ void done(const Unit&) const {}
};

__device__ __forceinline__ unsigned cvt_pk_bf16(float lo, float hi) { unsigned r; asm volatile("v_cvt_pk_bf16_f32 %0, %1, %2" : "=v"(r) : "v"(lo), "v"(hi)); return r; }
typedef float f32x2 __attribute__((ext_vector_type(2)));
typedef unsigned u32x2 __attribute__((ext_vector_type(2)));
struct EpiInProj {
    static constexpr bool PERM = true, AFTER_DRAIN = false;
    bf16_t *QS, *VR, *GS, *QA, *KA, *VA; float* G; float* kout; float* vout; const float* lbp;
    __device__ __forceinline__ void operator()(const f32x4 (&acc)[2][2][4][2], const Unit& u, int wr, int wc, int fr, int fq) const {
        const int grp = u.pn >> 1;
        const int cb = (u.pn & 1) * 256 + wc * 32 + 8 * fq;
        const int row0 = u.pm * BM + wr * 64 + fr;
        if (grp == 1) {
            float lb[2][8];
#pragma unroll
            for (int bj = 0; bj < 2; ++bj)
#pragma unroll
                for (int e = 0; e < 8; ++e) { const int c = cb + bj * HALF + e; lb[bj][e] = ::sigm(lbp[c] - lbp[512 + c]); }
#pragma unroll
            for (int ai = 0; ai < 2; ++ai)
#pragma unroll
                for (int m = 0; m < 4; ++m) { const size_t row = (size_t)(row0 + ai * HALF + m * 16);
#pragma unroll
                    for (int bj = 0; bj < 2; ++bj) { const f32x4 v0 = acc[ai][bj][m][0], v1 = acc[ai][bj][m][1]; f32x4 g0, g1;
#pragma unroll
                        for (int e = 0; e < 4; ++e) { const float f0 = lb[bj][e] + (1.0f - lb[bj][e]) * ::sigm(v0[e]), f1 = lb[bj][4 + e] + (1.0f - lb[bj][4 + e]) * ::sigm(v1[e]);
                            g0[e] = __builtin_amdgcn_logf(f0) * LN2; g1[e] = __builtin_amdgcn_logf(f1) * LN2; }
                        float* gp = G + row * 512 + cb + bj * HALF; *(f32x4*)gp = g0; *(f32x4*)(gp + 4) = g1; } }
        } else {
            bf16_t* dst = grp == 0 ? QS : grp == 2 ? VR : grp == 3 ? GS : grp == 4 ? QA : grp == 5 ? KA : VA;
            float* fo = grp == 5 ? kout : grp == 6 ? vout : nullptr;
            const bool act = (grp == 0 || grp == 3);
#pragma unroll
            for (int ai = 0; ai < 2; ++ai)
#pragma unroll
                for (int m = 0; m < 4; ++m) { const size_t row = (size_t)(row0 + ai * HALF + m * 16);
#pragma unroll
                    for (int bj = 0; bj < 2; ++bj) { f32x4 v0 = acc[ai][bj][m][0], v1 = acc[ai][bj][m][1];
                        const size_t off = row * 512 + cb + bj * HALF;
                        if (fo) { *(f32x4*)(fo + off) = v0; *(f32x4*)(fo + off + 4) = v1; }
                        if (act) {
#pragma unroll
                            for (int e = 0; e < 4; ++e) { v0[e] = ::siluf(v0[e]); v1[e] = ::siluf(v1[e]); } }
                        u32x4 w; w.x = cvt_pk_bf16(v0[0], v0[1]); w.y = cvt_pk_bf16(v0[2], v0[3]); w.z = cvt_pk_bf16(v1[0], v1[1]); w.w = cvt_pk_bf16(v1[2], v1[3]);
                        *(u32x4*)(dst + off) = w; } }
        }
    }
};
struct EpiWout {
    static constexpr bool PERM = false, AFTER_DRAIN = false;
    const float* X; float* X1; bf16_t* XB; float* PS1;
    __device__ __forceinline__ void operator()(const f32x4 (&acc)[2][2][4][2], const Unit& u, int wr, int wc, int fr, int fq) const {
        const int row0 = u.pm * BM + wr * 64 + fr, col0 = u.pn * BM + wc * 32 + 4 * fq;
#pragma unroll
        for (int ai = 0; ai < 2; ++ai)
#pragma unroll
            for (int m = 0; m < 4; ++m) { const size_t row = (size_t)(row0 + ai * HALF + m * 16); float ss = 0.f;
#pragma unroll
                for (int bj = 0; bj < 2; ++bj)
#pragma unroll
                    for (int n = 0; n < 2; ++n) { const size_t off = row * 1024 + col0 + bj * HALF + n * 16;
                        const f32x4 v = *(const f32x4*)(X + off) + acc[ai][bj][m][n]; *(f32x4*)(X1 + off) = v;
                        u32x2 w; w.x = cvt_pk_bf16(v[0], v[1]); w.y = cvt_pk_bf16(v[2], v[3]); *(u32x2*)(XB + off) = w;
                        ss += (v[0] * v[0] + v[1] * v[1]) + (v[2] * v[2] + v[3] * v[3]); }
                ss += __shfl_xor(ss, 16); ss += __shfl_xor(ss, 32);
                if (fq == 0) PS1[row * 16 + u.pn * 4 + wc] = ss; }
    }
};
struct EpiGateUp {
    static constexpr bool PERM = true, AFTER_DRAIN = false;
    const float* PS1; bf16_t* H;
    __device__ __forceinline__ void operator()(const f32x4 (&acc)[2][2][4][2], const Unit& u, int wr, int wc, int fr, int fq) const {
        const int row0 = u.pm * BM + wr * 64 + fr, f0 = (u.pn * BM + wc * 32 + 8 * fq) >> 1;
#pragma unroll
        for (int ai = 0; ai < 2; ++ai)
#pragma unroll
            for (int m = 0; m < 4; ++m) { const size_t row = (size_t)(row0 + ai * HALF + m * 16);
                const f32x4 p0 = *(const f32x4*)(PS1 + row * 16), p1 = *(const f32x4*)(PS1 + row * 16 + 4), p2 = *(const f32x4*)(PS1 + row * 16 + 8), p3 = *(const f32x4*)(PS1 + row * 16 + 12);
                const f32x4 ps = (p0 + p1) + (p2 + p3);
                const float rstd = __builtin_amdgcn_rsqf(((ps[0] + ps[1]) + (ps[2] + ps[3])) * (1.0f / 1024.0f) + EPS);
#pragma unroll
                for (int bj = 0; bj < 2; ++bj) { const f32x4 g = acc[ai][bj][m][0] * rstd, uu = acc[ai][bj][m][1] * rstd;
                    u32x2 w; w.x = cvt_pk_bf16(::siluf(g[0]) * uu[0], ::siluf(g[1]) * uu[1]); w.y = cvt_pk_bf16(::siluf(g[2]) * uu[2], ::siluf(g[3]) * uu[3]);
                    *(u32x2*)(H + row * 2816 + f0 + bj * 64) = w; } }
    }
};
struct EpiDown {
    static constexpr bool PERM = false, AFTER_DRAIN = false;
    const float* X1; float* OUT;
    __device__ __forceinline__ void operator()(const f32x4 (&acc)[2][2][4][2], const Unit& u, int wr, int wc, int fr, int fq) const {
        const int row0 = u.pm * BM + wr * 64 + fr, col0 = u.pn * BM + wc * 32 + 4 * fq;
#pragma unroll
        for (int ai = 0; ai < 2; ++ai)
#pragma unroll
            for (int m = 0; m < 4; ++m) { const size_t row = (size_t)(row0 + ai * HALF + m * 16);
#pragma unroll
                for (int bj = 0; bj < 2; ++bj)
#pragma unroll
                    for (int n = 0; n < 2; ++n) { const size_t off = row * 1024 + col0 + bj * HALF + n * 16;
                        *(f32x4*)(OUT + off) = *(const f32x4*)(X1 + off) + acc[ai][bj][m][n]; } }
    }
};
template <class Epi, class Sched, bool ALIGN_EPI = false, bool SP2 = false>
__device__ __forceinline__ void gemm_phase(PG8_LAS unsigned char* lds, const Gemm g, const Sched& S, const Epi& E) {
    const int tid = threadIdx.x, wid = __builtin_amdgcn_readfirstlane(tid >> 6), lane = tid & 63, wr = wid >> 2, wc = wid & 3, fr = lane & 15, fq = lane >> 4;
    const int K = g.K, nt = K / BK;
    unsigned voffA[2], voffB[2];
#pragma unroll
    for (int i = 0; i < 2; ++i) { int R, C; stage_rc(tid * 16 + i * 8192, R, C); const int Rb = Epi::PERM ? ((R & ~31) + perm32(R & 31)) : R;
        voffA[i] = (unsigned)(R * K + C) * 2u; voffB[i] = (unsigned)(Rb * K + C) * 2u; }
    const size_t kstep = (size_t)(BK * 2);
    const size_t hstep = (size_t)HALF * K * 2;
    const size_t tstep = 2 * hstep;
    const unsigned ldsw = (unsigned)wid * 1024u;
    const int aoff = lds_byte(wr * 64 + fr, fq * 8), boff = lds_byte(wc * 32 + fr, fq * 8);
#define PG8_SA(b, h) (((b) * 2 + (h)) * HTB)
#define PG8_SB(b, h) ((4 + (b) * 2 + (h)) * HTB)
#define PG8_STAGE(bufoff, gbase, voff) do { _Pragma("unroll") for (int _i = 0; _i < 2; ++_i) \
        __builtin_amdgcn_global_load_lds((const unsigned*)((const char*)(gbase) + (voff)[_i]), (PG8_LAS unsigned*)(lds + (bufoff) + ldsw + _i * 8192), 16, 0, 0); } while (0)
#define PG8_LDA(dst, b, h) do { _Pragma("unroll") for (int m = 0; m < 4; ++m) _Pragma("unroll") for (int k = 0; k < 2; ++k) dst[m][k] = *(const PG8_LAS bf16x8*)(lds + PG8_SA(b, h) + aoff + m * 2048 + k * 1024); } while (0)
#define PG8_LDB(dst, b, h) do { _Pragma("unroll") for (int n = 0; n < 2; ++n) _Pragma("unroll") for (int k = 0; k < 2; ++k) dst[n][k] = *(const PG8_LAS bf16x8*)(lds + PG8_SB(b, h) + boff + n * 2048 + k * 1024); } while (0)
#define PG8_MMA(ai, bj, At, Bt) do { __builtin_amdgcn_s_setprio(1); _Pragma("unroll") for (int m = 0; m < 4; ++m) _Pragma("unroll") for (int n = 0; n < 2; ++n) _Pragma("unroll") for (int k = 0; k < 2; ++k) \
        acc[ai][bj][m][n] = __builtin_amdgcn_mfma_f32_16x16x32_bf16(Bt[n][k], At[m][k], acc[ai][bj][m][n], 0, 0, 0); __builtin_amdgcn_s_setprio(0); } while (0)
#define PG8_WAIT_V(n) asm volatile("s_waitcnt vmcnt(" #n ")" ::: "memory")
#define PG8_WAIT_L(n) asm volatile("s_waitcnt lgkmcnt(" #n ")" ::: "memory")
#define PG8_BAR __builtin_amdgcn_s_barrier()
#define PG8_SCHED __builtin_amdgcn_sched_barrier(0)
    Unit cur, nxt; int ui = 0;
    if (!S.next(0, cur)) return;
    f32x4 acc[2][2][4][2];
#pragma unroll
    for (int a = 0; a < 2; ++a)
#pragma unroll
        for (int b = 0; b < 2; ++b)
#pragma unroll
            for (int m = 0; m < 4; ++m)
#pragma unroll
                for (int n = 0; n < 2; ++n) acc[a][b][m][n] = (f32x4){0.f, 0.f, 0.f, 0.f};
    bf16x8 At[4][2], B0[2][2], B1[2][2];
    const char* cA = (const char*)g.A + (size_t)cur.pm * tstep; const char* cB = (const char*)g.Bt + (size_t)cur.pn * tstep;
    S.a_ready(cur);
    if constexpr (SP2) {
        PG8_STAGE(PG8_SB(0, 0), cB, voffB); PG8_STAGE(PG8_SB(0, 1), cB + hstep, voffB); PG8_STAGE(PG8_SA(0, 0), cA, voffA); PG8_STAGE(PG8_SA(0, 1), cA + hstep, voffA);
        if (wr == 1) PG8_BAR;
        PG8_WAIT_V(2); PG8_BAR;
        PG8_STAGE(PG8_SB(1, 0), cB + kstep, voffB); PG8_STAGE(PG8_SA(1, 0), cA + kstep, voffA); PG8_STAGE(PG8_SB(1, 1), cB + hstep + kstep, voffB);
        PG8_WAIT_V(6); PG8_BAR;
    } else {
        PG8_STAGE(PG8_SB(0, 0), cB, voffB); PG8_STAGE(PG8_SA(0, 0), cA, voffA); PG8_STAGE(PG8_SB(0, 1), cB + hstep, voffB); PG8_STAGE(PG8_SA(0, 1), cA + hstep, voffA);
        if (wr == 1) PG8_BAR;
        PG8_WAIT_V(4); PG8_BAR;
        PG8_STAGE(PG8_SB(1, 0), cB + kstep, voffB); PG8_STAGE(PG8_SA(1, 0), cA + kstep, voffA); PG8_STAGE(PG8_SB(1, 1), cB + hstep + kstep, voffB);
        PG8_WAIT_V(6); PG8_BAR;
    }
    for (;;) {
        const bool has_next = S.next(ui + 1, nxt);
        const char* nA = has_next ? (const char*)g.A + (size_t)nxt.pm * tstep : cA; const char* nB = has_next ? (const char*)g.Bt + (size_t)nxt.pn * tstep : cB;
        for (int t = 0; t < nt; t += 2) {
            const bool last = (t == nt - 2);
            const char* a1 = cA + (size_t)(t + 1) * kstep;
            const char* a2 = last ? nA : cA + (size_t)(t + 2) * kstep; const char* b2 = last ? nB : cB + (size_t)(t + 2) * kstep;
            const char* a3 = a2 + kstep; const char* b3 = b2 + kstep;
            if (last && has_next) S.a_ready(nxt);
            if constexpr (SP2) {
            PG8_LDB(B0, 0, 0); PG8_LDB(B1, 0, 1); PG8_SCHED; PG8_LDA(At, 0, 0); PG8_STAGE(PG8_SA(1, 1), a1 + hstep, voffA);
            PG8_WAIT_V(8); PG8_WAIT_L(0); PG8_BAR; PG8_MMA(0, 0, At, B0); PG8_MMA(0, 1, At, B1); PG8_BAR; PG8_SCHED;
            PG8_LDA(At, 0, 1); PG8_STAGE(PG8_SB(0, 0), b2, voffB); PG8_STAGE(PG8_SB(0, 1), b2 + hstep, voffB); PG8_STAGE(PG8_SA(0, 0), a2, voffA);
            PG8_WAIT_V(8); PG8_WAIT_L(0); PG8_BAR; PG8_MMA(1, 0, At, B0); PG8_MMA(1, 1, At, B1); PG8_BAR; PG8_SCHED;
            PG8_LDB(B0, 1, 0); PG8_LDB(B1, 1, 1); PG8_SCHED; PG8_LDA(At, 1, 0); PG8_STAGE(PG8_SA(0, 1), a2 + hstep, voffA);
            PG8_WAIT_V(8); PG8_WAIT_L(0); PG8_BAR; PG8_MMA(0, 0, At, B0); PG8_MMA(0, 1, At, B1); PG8_BAR; PG8_SCHED;
            PG8_LDA(At, 1, 1); PG8_STAGE(PG8_SB(1, 0), b3, voffB); PG8_STAGE(PG8_SB(1, 1), b3 + hstep, voffB); PG8_STAGE(PG8_SA(1, 0), a3, voffA);
            PG8_WAIT_V(8); PG8_WAIT_L(0); PG8_BAR; PG8_MMA(1, 0, At, B0); PG8_MMA(1, 1, At, B1); PG8_BAR; PG8_SCHED;
            } else {
            PG8_LDB(B0, 0, 0); PG8_SCHED; PG8_LDA(At, 0, 0); PG8_STAGE(PG8_SA(1, 1), a1 + hstep, voffA);
            PG8_WAIT_L(8); PG8_BAR; PG8_WAIT_L(0); PG8_MMA(0, 0, At, B0); PG8_BAR; PG8_SCHED;
            PG8_LDB(B1, 0, 1); PG8_STAGE(PG8_SB(0, 0), b2, voffB);
            PG8_BAR; PG8_WAIT_L(0); PG8_MMA(0, 1, At, B1); PG8_BAR;
            PG8_LDA(At, 0, 1); PG8_STAGE(PG8_SA(0, 0), a2, voffA);
            PG8_BAR; PG8_WAIT_L(0); PG8_MMA(1, 0, At, B0); PG8_BAR; PG8_SCHED;
            PG8_STAGE(PG8_SB(0, 1), b2 + hstep, voffB);
            PG8_WAIT_V(6); PG8_BAR; PG8_MMA(1, 1, At, B1); PG8_BAR;
            PG8_LDB(B0, 1, 0); PG8_SCHED; PG8_LDA(At, 1, 0); PG8_STAGE(PG8_SA(0, 1), a2 + hstep, voffA);
            PG8_WAIT_L(8); PG8_BAR; PG8_WAIT_L(0); PG8_MMA(0, 0, At, B0); PG8_BAR; PG8_SCHED;
            PG8_LDB(B1, 1, 1); PG8_STAGE(PG8_SB(1, 0), b3, voffB);
            PG8_BAR; PG8_WAIT_L(0); PG8_MMA(0, 1, At, B1); PG8_BAR;
            PG8_LDA(At, 1, 1); PG8_STAGE(PG8_SA(1, 0), a3, voffA);
            PG8_BAR; PG8_WAIT_L(0); PG8_MMA(1, 0, At, B0); PG8_BAR; PG8_SCHED;
            PG8_STAGE(PG8_SB(1, 1), b3 + hstep, voffB);
            PG8_WAIT_V(6); PG8_BAR; PG8_MMA(1, 1, At, B1); PG8_BAR;
            }
        }
        if constexpr (ALIGN_EPI) { if (wr == 0) PG8_BAR; }
        if constexpr (!Epi::AFTER_DRAIN) { E(acc, cur, wr, wc, fr, fq); S.done(cur); }
        if (!has_next) break;
#pragma unroll
        for (int a = 0; a < 2; ++a)
#pragma unroll
            for (int b = 0; b < 2; ++b)
#pragma unroll
                for (int m = 0; m < 4; ++m)
#pragma unroll
                    for (int n = 0; n < 2; ++n) acc[a][b][m][n] = (f32x4){0.f, 0.f, 0.f, 0.f};
        cur = nxt; cA = nA; cB = nB; ++ui;
        if constexpr (ALIGN_EPI) { if (wr == 1) PG8_BAR; }
    }
    PG8_WAIT_V(0);
    if constexpr (!ALIGN_EPI) { if (wr == 0) PG8_BAR; }
    PG8_BAR;
    if constexpr (Epi::AFTER_DRAIN) { E.fused(acc, cur, wr, wc, fr, fq, lds, wid, lane); S.done(cur); }
#undef PG8_SA
#undef PG8_SB
#undef PG8_STAGE
#undef PG8_LDA
#undef PG8_LDB
#undef PG8_MMA
#undef PG8_WAIT_V
#undef PG8_WAIT_L
#undef PG8_BAR
#undef PG8_SCHED
}
}
namespace att {
typedef short s16x4 __attribute__((ext_vector_type(4)));
constexpr int NW = 8, QBLK = 32, KVBLK = 64, QB = 128, D = 128, PITCH = 512, OPITCH = 1024;
constexpr int SHM_V = KVBLK * D * 2, SHM_K = KVBLK * D * 2;
constexpr int LDS_WS = 2 * SHM_V + 2 * SHM_K, LDS_XCH = LDS_WS + NW * 64 * 4, LDS_BYTES = LDS_XCH + 4 * 32 * 128 * 4;
constexpr float SCALE = 0.125f, THR = 8.f;
constexpr unsigned WBIG = 0x40000000u;
#define KSWZ(row, colB) ((row) * 256 + ((colB) ^ (((row) & 7) << 4)))
#define SBAR() __builtin_amdgcn_sched_barrier(0)
__device__ __forceinline__ int v_st(int k, int c) { const int kk = (k & ~0xC) | ((k & 4) << 1) | ((k & 8) >> 1); return ((kk >> 3) * 4 + (c >> 5)) * 512 + ((kk & 7) * 32 + (c & 31)) * 2; }
__device__ __forceinline__ int v_rd_base(int lane) { return ((lane & 3) << 3) | (((lane >> 2) & 3) << 6) | (((lane >> 4) & 1) << 5) | (((lane >> 5) & 1) << 8); }
constexpr int v_rd_off(int d0, int ks, int half) { return d0 * 512 + ks * 4096 + half * 2048; }
__device__ __forceinline__ int crow(int r, int hi) { return (r & 3) + 8 * (r >> 2) + 4 * hi; }
__device__ __forceinline__ unsigned cvtpk(float lo, float hi) { unsigned r; asm volatile("v_cvt_pk_bf16_f32 %0, %1, %2" : "=v"(r) : "v"(lo), "v"(hi)); return r; }
__device__ __forceinline__ bf16x8 load8(const bf16* p) { return *reinterpret_cast<const bf16x8*>(p); }
__device__ __forceinline__ void mask_tile(f32x16& p0, f32x16& p1, int dq, unsigned W) {
    const float NEG = -__builtin_inff();
#pragma unroll
    for (int r = 0; r < 16; ++r) {
        const int c = (r & 3) + 8 * (r >> 2);
        if ((unsigned)(dq - c) >= W) p0[r] = NEG;
        if ((unsigned)(dq - c - 32) >= W) p1[r] = NEG;
    }
}
__device__ __forceinline__ void partialSM(f32x16& p0, f32x16& p1, float& m_reg, float& mn, float& alpha) {
    float pmax = p0[0];
#pragma unroll
    for (int r = 1; r < 16; ++r) pmax = fmaxf(pmax, p0[r]);
#pragma unroll
    for (int r = 0; r < 16; ++r) pmax = fmaxf(pmax, p1[r]);
    { auto rr = __builtin_amdgcn_permlane32_swap(__float_as_uint(pmax), __float_as_uint(pmax), false, false);
      pmax = fmaxf(__uint_as_float(rr[0]), __uint_as_float(rr[1])); }
    constexpr float C2 = 1.4426950408889634f * SCALE;
    if (__builtin_expect(__all((pmax - m_reg) * SCALE <= THR), 1)) { mn = m_reg; alpha = 1.f; }
    else { mn = fmaxf(m_reg, pmax); alpha = __builtin_amdgcn_exp2f((m_reg - mn) * C2); m_reg = mn; }
    const float mnL = -mn * C2;
#pragma unroll
    for (int r = 0; r < 16; ++r) p0[r] = fmaf(p0[r], C2, mnL);
#pragma unroll
    for (int r = 0; r < 16; ++r) p1[r] = fmaf(p1[r], C2, mnL);
#pragma unroll
    for (int r = 0; r < 16; ++r) p0[r] = __builtin_amdgcn_exp2f(p0[r]);
}
__device__ __forceinline__ void finishSM(f32x16& p0, f32x16& p1, float alpha, float& l_reg, bf16x8& pa0, bf16x8& pa1, bf16x8& pa2, bf16x8& pa3) {
#pragma unroll
    for (int r = 0; r < 16; ++r) p1[r] = __builtin_amdgcn_exp2f(p1[r]);
    float ps = 0;
#pragma unroll
    for (int r = 0; r < 16; ++r) ps += p0[r];
#pragma unroll
    for (int r = 0; r < 16; ++r) ps += p1[r];
    { auto rr = __builtin_amdgcn_permlane32_swap(__float_as_uint(ps), __float_as_uint(ps), false, false);
      ps = __uint_as_float(rr[0]) + __uint_as_float(rr[1]); }
    l_reg = l_reg * alpha + ps;
#define PK4(P, B_, OUT) do { unsigned a0 = cvtpk(P[B_+0], P[B_+1]), a1 = cvtpk(P[B_+2], P[B_+3]);                          \
        unsigned b0 = cvtpk(P[B_+4], P[B_+5]), b1 = cvtpk(P[B_+6], P[B_+7]);                                             \
        auto r0 = __builtin_amdgcn_permlane32_swap(a0, b0, false, false); auto r1 = __builtin_amdgcn_permlane32_swap(a1, b1, false, false); \
        v4u w = {r0[0], r1[0], r0[1], r1[1]}; OUT = *reinterpret_cast<bf16x8*>(&w); } while (0)
    PK4(p0, 0, pa0); PK4(p0, 8, pa1); PK4(p1, 0, pa2); PK4(p1, 8, pa3);
#undef PK4
}
template <int KB>
__device__ __forceinline__ void qkt(f32x16& p0, f32x16& p1, const char* K_lds, int r32, int hi, const bf16x8* qr, int kcolB) {
    p0 = f32x16{}; p1 = f32x16{};
#pragma unroll
    for (int d0 = 0; d0 < 4; ++d0) { const char* a = K_lds + KB * SHM_K + KSWZ(r32, (d0 * 16 + hi * 8) * 2 + kcolB);
        bf16x8 b0 = *reinterpret_cast<const bf16x8*>(a);
        bf16x8 b1 = *reinterpret_cast<const bf16x8*>(a + 32 * 256);
        p0 = __builtin_amdgcn_mfma_f32_32x32x16_bf16(b0, qr[d0], p0, 0, 0, 0);
        p1 = __builtin_amdgcn_mfma_f32_32x32x16_bf16(b1, qr[d0], p1, 0, 0, 0); }
}
template <int VB>
__device__ __forceinline__ void pv_tile(f32x16* o, int vb0, bf16x8 pa0, bf16x8 pa1, bf16x8 pa2, bf16x8 pa3) {
#define TRRD(dst, off) asm volatile("ds_read_b64_tr_b16 %0, %1 offset:%2" : "=&v"(dst) : "v"(vb0), "i"(off) : "memory")
#define PV_D0(d0) do { s16x4 l0, l1, l2, l3, h0, h1, h2, h3; constexpr int b_ = VB * SHM_V + v_rd_off(d0, 0, 0);     \
        TRRD(l0, b_); TRRD(h0, b_ + 2048); TRRD(l1, b_ + 4096); TRRD(h1, b_ + 6144); TRRD(l2, b_ + 8192); TRRD(h2, b_ + 10240); TRRD(l3, b_ + 12288); TRRD(h3, b_ + 14336); \
        asm volatile("s_waitcnt lgkmcnt(0)" ::: "memory"); SBAR();                 \
        o[d0] = __builtin_amdgcn_mfma_f32_32x32x16_bf16(pa0, (bf16x8){l0[0], l0[1], l0[2], l0[3], h0[0], h0[1], h0[2], h0[3]}, o[d0], 0, 0, 0);   \
        o[d0] = __builtin_amdgcn_mfma_f32_32x32x16_bf16(pa1, (bf16x8){l1[0], l1[1], l1[2], l1[3], h1[0], h1[1], h1[2], h1[3]}, o[d0], 0, 0, 0);   \
        o[d0] = __builtin_amdgcn_mfma_f32_32x32x16_bf16(pa2, (bf16x8){l2[0], l2[1], l2[2], l2[3], h2[0], h2[1], h2[2], h2[3]}, o[d0], 0, 0, 0);   \
        o[d0] = __builtin_amdgcn_mfma_f32_32x32x16_bf16(pa3, (bf16x8){l3[0], l3[1], l3[2], l3[3], h3[0], h3[1], h3[2], h3[3]}, o[d0], 0, 0, 0); } while (0)
    PV_D0(0); PV_D0(1); PV_D0(2); PV_D0(3);
#undef PV_D0
#undef TRRD
}
struct BlockRef { const bf16* Q; const bf16* K; const bf16* V; bf16* O; int P0; };
struct Seam { bf16x8 qr[4]; bf16x8 st_v0, st_v1, st_k0, st_k1; };
struct Consts { float lam, oscale; const float* subln; };
#define AROW(p, k0, rr) ((p) + (size_t)((k0) + (rr)) * PITCH + sc)
#define VMW() asm volatile("s_waitcnt vmcnt(0)" ::: "memory")
#define VMWN(n) asm volatile("s_waitcnt vmcnt(%0)" :: "i"(n) : "memory")
#define SLOAD_H(Kp, Vp, k0) do { S.st_v0 = load8(AROW(Vp, k0, sr)); S.st_v1 = load8(AROW(Vp, k0, 32 + sr));              \
                         S.st_k0 = load8(AROW(Kp, k0, sr)); S.st_k1 = load8(AROW(Kp, k0, 32 + sr)); } while (0)
#define SWRITE_HK(bf) do { *(bf16x8*)(K_lds + (bf) * SHM_K + kws) = S.st_k0; *(bf16x8*)(K_lds + (bf) * SHM_K + kws + 32 * 256) = S.st_k1; } while (0)
#define SWRITE_HV(bf) do { *(bf16x8*)(V_lds + (bf) * SHM_V + vst0) = S.st_v0; *(bf16x8*)(V_lds + (bf) * SHM_V + vst1) = S.st_v1; } while (0)
#define SWRITE_H(bf) do { SWRITE_HV(bf); SWRITE_HK(bf); } while (0)
__device__ __forceinline__ void prime(const BlockRef& cur, char* lds, Seam& S) {
    const int tid = threadIdx.x, wid = __builtin_amdgcn_readfirstlane(tid >> 6), lane = tid & 63, r32 = lane & 31, hi = lane >> 5;
    const int mw = wid >> 2, wq = wid & 3;
    const int sr = tid >> 4, sc = (tid & 15) * 8, kws = KSWZ(sr, sc * 2); char* K_lds = lds + 2 * SHM_V;
#pragma unroll
    for (int d0 = 0; d0 < 4; ++d0) S.qr[d0] = load8(cur.Q + (size_t)(wq * QBLK + r32) * PITCH + mw * 64 + d0 * 16 + hi * 8);
    SLOAD_H(cur.K, cur.V, 0); VMW(); SWRITE_HK(0);
    __syncthreads();
}
__device__ __forceinline__ void block(const BlockRef& cur, const BlockRef& nxt, char* lds, Seam& S, const Consts& C) {
    const int tid = threadIdx.x, wid = __builtin_amdgcn_readfirstlane(tid >> 6), lane = tid & 63, r32 = lane & 31, hi = lane >> 5;
    const int mw = wid >> 2, wq = wid & 3;
    const int NT = cur.P0 / KVBLK + 2;
    const int qlo = cur.P0 + wq * QBLK, qm = qlo + r32 - 4 * hi;
    char* V_lds = lds; char* K_lds = lds + 2 * SHM_V;
    float* ws = (float*)(lds + LDS_WS) + wid * 64; float* li_l = ws, * al_l = ws + 32;
    float m_reg = -1e30f, l_reg = 0; f32x16 o[4] = {};
    const int sr = tid >> 4, sc = (tid & 15) * 8, vst0 = v_st(sr, sc), vst1 = v_st(32 + sr, sc), kws = KSWZ(sr, sc * 2);
    const int vb0 = (int)(uintptr_t)V_lds + v_rd_base(lane);
    const int kcolB = mw * 128;
    const bf16* Kh = cur.K; const bf16* Vh = cur.V;
#define RESC(a) do { if (__any((a) < 1.f)) { if (hi == 0) al_l[r32] = (a); asm volatile("s_waitcnt lgkmcnt(0)" ::: "memory");              \
                     for (int d_ = 0; d_ < 4; ++d_) for (int r = 0; r < 16; ++r) o[d_][r] *= al_l[crow(r, hi)]; } } while (0)
#define KBASE(t) ((t) * KVBLK)
#define MASKT(P0_, P1_, t) do { const int kb_ = KBASE(t); if (kb_ + KVBLK - 1 > qlo) mask_tile(P0_, P1_, qm - kb_, WBIG); } while (0)
    constexpr int NQL = 4;
#define SEAM_K0() do { VMWN(NQL); SWRITE_HK(0); SBAR(); } while (0)
    f32x16 pA0, pA1, pB0, pB1; float mnA, mnB, alA, alB; bf16x8 pa0, pa1, pa2, pa3;
    SWRITE_HV(0); SBAR();
    if (NT > 1) { SLOAD_H(Kh, Vh, KBASE(1)); }
    SBAR(); qkt<0>(pA0, pA1, K_lds, r32, hi, S.qr, kcolB);
    MASKT(pA0, pA1, 0); partialSM(pA0, pA1, m_reg, mnA, alA);
    if (NT > 1) { VMW(); SWRITE_H(1); }
    __syncthreads();
#define HALF_STEP(PX0, PX1, mnX, alX, PY0, PY1, alY, t, KB, VB, SB) do {                                                      \
        SBAR(); qkt<KB>(PX0, PX1, K_lds, r32, hi, S.qr, kcolB);                                                               \
        finishSM(PY0, PY1, alY, l_reg, pa0, pa1, pa2, pa3); SBAR();                                                           \
        if ((t) + 1 < NT) { SLOAD_H(Kh, Vh, KBASE((t) + 1)); SBAR(); }                                                        \
        pv_tile<VB>(o, vb0, pa0, pa1, pa2, pa3); MASKT(PX0, PX1, (t)); partialSM(PX0, PX1, m_reg, mnX, alX);                  \
        __syncthreads();                                                                                                      \
        if ((t) + 1 < NT) { VMW(); SWRITE_H(SB); }                                                                            \
        RESC(alX); __syncthreads(); } while (0)
    for (int t = 1; t + 1 < NT; t += 2) {
        HALF_STEP(pB0, pB1, mnB, alB, pA0, pA1, alA, t, 1, 0, 0);
        HALF_STEP(pA0, pA1, mnA, alA, pB0, pB1, alB, t + 1, 0, 1, 1);
    }
    const bool even = (NT & 1) == 0;
    if (even) { SBAR(); qkt<1>(pB0, pB1, K_lds, r32, hi, S.qr, kcolB); SBAR(); }
    SLOAD_H(nxt.K, nxt.V, 0); SBAR();
#pragma unroll
    for (int d0 = 0; d0 < 4; ++d0) S.qr[d0] = load8(nxt.Q + (size_t)(wq * QBLK + r32) * PITCH + mw * 64 + d0 * 16 + hi * 8);
    SBAR();
    finishSM(pA0, pA1, alA, l_reg, pa0, pa1, pa2, pa3); SBAR();
    pv_tile<0>(o, vb0, pa0, pa1, pa2, pa3);
    if (even) { MASKT(pB0, pB1, NT - 1); partialSM(pB0, pB1, m_reg, mnB, alB); __syncthreads(); RESC(alB);
        finishSM(pB0, pB1, alB, l_reg, pa0, pa1, pa2, pa3); SBAR(); pv_tile<1>(o, vb0, pa0, pa1, pa2, pa3); }
    SBAR(); SEAM_K0();
    int r32e = r32, hie = hi; asm volatile("" : "+v"(r32e), "+v"(hie));
    if (hie == 0) li_l[r32e] = l_reg; asm volatile("s_waitcnt lgkmcnt(0)" ::: "memory");
    float rli[16];
#pragma unroll
    for (int r = 0; r < 16; ++r) rli[r] = __builtin_amdgcn_rcpf(li_l[crow(r, hie)]);
    float* xch = (float*)(lds + LDS_XCH) + wq * (32 * 128);
    if (mw == 1) {
#pragma unroll
        for (int r = 0; r < 16; ++r) { const int orow = crow(r, hie);
#pragma unroll
            for (int d0 = 0; d0 < 4; ++d0) xch[orow * 128 + d0 * 32 + r32e] = o[d0][r] * rli[r]; }
    }
    __syncthreads();
    if (mw == 0) {
        bf16* Ow = cur.O + (size_t)(wq * QBLK) * OPITCH;
        float sub[4];
#pragma unroll
        for (int d0 = 0; d0 < 4; ++d0) sub[d0] = C.subln[d0 * 32 + r32e];
#pragma unroll
        for (int r = 0; r < 16; ++r) { const int orow = crow(r, hie); float a[4]; float ss = 0.f;
#pragma unroll
            for (int d0 = 0; d0 < 4; ++d0) { a[d0] = o[d0][r] * rli[r] - C.lam * xch[orow * 128 + d0 * 32 + r32e]; ss += a[d0] * a[d0]; }
#pragma unroll
            for (int ofs = 1; ofs < 32; ofs <<= 1) ss += __shfl_xor(ss, ofs);
            const float rs = __builtin_amdgcn_rsqf(ss * (1.0f / 128.0f) + EPS) * C.oscale;
#pragma unroll
            for (int d0 = 0; d0 < 4; ++d0) { const float v = a[d0] * rs * sub[d0]; const float vn = __shfl_xor(v, 1);
                if ((r32e & 1) == 0) *(unsigned*)(Ow + (size_t)orow * OPITCH + d0 * 32 + r32e) = cvtpk(v, vn); } }
    }
    __syncthreads();
#undef RESC
#undef KBASE
#undef MASKT
#undef SEAM_K0
#undef HALF_STEP
}
__device__ __forceinline__ BlockRef mkref(int L, int pass, const bf16* QA, const bf16* KA, const bf16* VA, bf16* MRG) {
    const int bh = L & 7, b = bh >> 2, h = bh & 3, y = L >> 3, qb = pass ? 63 - y : y;
    BlockRef r; r.P0 = qb * QB;
    r.Q = QA + ((size_t)b * SEQ + r.P0) * PITCH + h * 128; r.K = KA + (size_t)b * SEQ * PITCH + h * 128; r.V = VA + (size_t)b * SEQ * PITCH + h * 128;
    r.O = MRG + ((size_t)b * SEQ + r.P0) * OPITCH + 512 + h * 128;
    return r;
}
__device__ __forceinline__ void attn_phase(char* lds, const bf16* QA, const bf16* KA, const bf16* VA, bf16* MRG, const Consts& C, int G, int bx) {
    constexpr int total = 256;
    int L = bx; if (L >= total) return;
    int pass = 0;
    BlockRef cur = mkref(L, 0, QA, KA, VA, MRG);
    Seam S;
    prime(cur, lds, S);
    for (;;) {
        const bool more_pass = pass == 0, more_item = L + G < total, last = !more_pass && !more_item;
        int passn = pass + 1, Ln = L;
        if (!more_pass) { passn = 0; Ln = more_item ? L + G : L; }
        const BlockRef nxt = last ? cur : mkref(Ln, passn, QA, KA, VA, MRG);
        block(cur, nxt, lds, S, C);
        if (last) break;
        cur = nxt; pass = passn; L = Ln;
    }
}
#undef AROW
#undef VMW
#undef VMWN
#undef SLOAD_H
#undef SWRITE_HK
#undef SWRITE_HV
#undef SWRITE_H
#undef KSWZ
#undef SBAR
}
#define XB_TMO      128
#define XB_XCNT(j)  (256  + 64 * (j))
#define XB_XSUB(j)  (1280 + 64 * (j))
#define XB_XGEN(j)  (2304 + 64 * (j))
#define XB_TOP      3328
#define XB_TOPGEN   3392
#define XCD_BAR_WORDS 3456
#define XB_SPIN_CAP (1u << 18)

__device__ __forceinline__ unsigned xb_ld(unsigned* p)              { return __hip_atomic_load(p, __ATOMIC_RELAXED, __HIP_MEMORY_SCOPE_AGENT); }
__device__ __forceinline__ unsigned xb_add(unsigned* p, unsigned v) { return __hip_atomic_fetch_add(p, v, __ATOMIC_RELAXED, __HIP_MEMORY_SCOPE_AGENT); }
__device__ __forceinline__ unsigned xb_xcc_id() { return (unsigned)__builtin_amdgcn_s_getreg((3 << 11) | 20) & 0xFu; }
#define XB_SPIN(cond, bar) do { unsigned _sp = 0; while (cond) { __builtin_amdgcn_s_sleep(1); \
    if ((++_sp & 255u) == 0u) { if (xb_ld(&(bar)[XB_TMO])) break; if (_sp > XB_SPIN_CAP) { atomicAdd(&(bar)[XB_TMO], 1u); break; } } } } while (0)

struct XcdBarrier {
    unsigned* bar; unsigned x;
    volatile LAS unsigned* st;
};

__device__ __forceinline__ XcdBarrier xcd_barrier_post(unsigned* bar, volatile LAS unsigned* st) {
    XcdBarrier b; b.bar = bar; b.x = xb_xcc_id(); b.st = st;
    if (threadIdx.x == 0) (void)xb_add(&bar[XB_XCNT(b.x)], 1u);
    return b;
}
__device__ __forceinline__ void xcd_barrier_complete(unsigned* bar, unsigned x, unsigned& nloc, unsigned& nx) {
    const unsigned G = gridDim.x * gridDim.y * gridDim.z;
    unsigned sum, cnt, mine, sp = 0u;
    for (;;) {
        sum = 0u; cnt = 0u; mine = 0u;
#pragma unroll
        for (unsigned j = 0; j < 16; ++j) { const unsigned c = xb_ld(&bar[XB_XCNT(j)]); sum += c; cnt += (c > 0u) ? 1u : 0u; mine = (j == x) ? c : mine; }
        if (sum == G) break;
        __builtin_amdgcn_s_sleep(1);
        if ((++sp & 255u) == 0u) { if (xb_ld(&bar[XB_TMO])) break; if (sp > XB_SPIN_CAP) { atomicAdd(&bar[XB_TMO], 1u); break; } }
    }
    nloc = mine > 0u ? mine : 1u; nx = cnt > 0u ? cnt : 1u;
}

__device__ __forceinline__ void xcd_barrier(const XcdBarrier& b) {
    asm volatile("s_waitcnt vmcnt(0)" ::: "memory");
    __syncthreads();
    if (threadIdx.x == 0) {
        unsigned* bar = b.bar;
        __builtin_amdgcn_s_waitcnt(0);
        unsigned nloc = b.st[0], nx = b.st[1];
        if (nloc == 0u) { xcd_barrier_complete(bar, b.x, nloc, nx); b.st[0] = nloc; b.st[1] = nx; }
        const unsigned old = xb_add(&bar[XB_XSUB(b.x)], 1u);
        const unsigned gen = old / nloc;
        if (old + 1u == (gen + 1u) * nloc) {
            __builtin_amdgcn_fence(__ATOMIC_RELEASE, "agent");
            asm volatile("s_waitcnt vmcnt(0)" ::: "memory");
            const unsigned og = xb_add(&bar[XB_TOP], 1u);
            const unsigned tg = og / nx;
            if (og + 1u == (tg + 1u) * nx) xb_add(&bar[XB_TOPGEN], 1u);
            else XB_SPIN(xb_ld(&bar[XB_TOPGEN]) == tg, bar);
            __builtin_amdgcn_fence(__ATOMIC_ACQUIRE, "agent");
            xb_add(&bar[XB_XGEN(b.x)], 1u);
            asm volatile("s_waitcnt vmcnt(0)" ::: "memory");
        } else {
            XB_SPIN(xb_ld(&bar[XB_XGEN(b.x)]) == gen, bar);
            __builtin_amdgcn_fence(__ATOMIC_ACQUIRE, "agent");
            asm volatile("s_waitcnt vmcnt(0)" ::: "memory");
        }
    }
    __syncthreads();
}
constexpr int NWAVES = 8;
__device__ __forceinline__ f32x16 mfma32(bf16x8 a, bf16x8 b, f32x16 c) { return __builtin_amdgcn_mfma_f32_32x32x16_bf16(a, b, c, 0, 0, 0); }
__device__ __forceinline__ int crow32(int r, int hi) { return (r & 3) + 8 * (r >> 2) + 4 * hi; }
__device__ __forceinline__ f32x16 mm32(const unsigned char* A, int astr, const unsigned char* B, int bstr, int ksteps, int r, int hh) {
    f32x16 acc = {};
    for (int s = 0; s < ksteps; ++s) {
        const bf16x8 a = *(const bf16x8*)(A + r * astr + (16 * s + 8 * hh) * 2);
        const bf16x8 b = *(const bf16x8*)(B + r * bstr + (16 * s + 8 * hh) * 2);
        acc = mfma32(a, b, acc);
    }
    return acc;
}

template <int MODE>
__device__ __forceinline__ void p0_transpose_item(const float* W, int K, int N, bf16* WT, const float* kscale, float* scr, int item, int lane) {
    const int nblk = N / 32, kb = item / nblk, nb = item % nblk, k0 = 64 * kb, n0 = 32 * nb;
#pragma unroll 8
    for (int i = 0; i < 32; ++i) { const int kk = 2 * i + (lane >> 5); float w = W[(size_t)(k0 + kk) * N + n0 + (lane & 31)]; if (kscale) w *= kscale[k0 + kk]; scr[kk * 33 + (lane & 31)] = w; }
    LDS_WAIT(); asm volatile("" ::: "memory");
    const int c = lane & 7;
#pragma unroll
    for (int j = 0; j < 4; ++j) { const int n = (lane >> 3) + 8 * j; const float* s = scr + (8 * c) * 33 + n;
        v4u o; o.x = pk2(s[0 * 33], s[1 * 33]); o.y = pk2(s[2 * 33], s[3 * 33]); o.z = pk2(s[4 * 33], s[5 * 33]); o.w = pk2(s[6 * 33], s[7 * 33]);
        const int gn = n0 + n; const int drow = MODE == 0 ? gn : ((gn >> 2) * 8 + (gn & 3) + (MODE == 2 ? 4 : 0));
        *(v4u*)(WT + (size_t)drow * K + k0 + 8 * c) = o; }
    LDS_WAIT(); asm volatile("" ::: "memory");
}
__device__ __forceinline__ void rms_row_to_bf16(const float* xrow, const float* gain, bf16* orow, int lane) {
    const f32x4* xr = (const f32x4*)xrow + lane; const f32x4* gr = (const f32x4*)gain + lane;
    f32x4 v[4]; float s = 0.f;
#pragma unroll
    for (int j = 0; j < 4; ++j) { v[j] = xr[64 * j]; s += (v[j].x * v[j].x + v[j].y * v[j].y) + (v[j].z * v[j].z + v[j].w * v[j].w); }
    const float rstd = __builtin_amdgcn_rsqf(wave_sum(s) * (1.f / DM) + EPS);
    unsigned long long* o8 = (unsigned long long*)orow + lane;
#pragma unroll
    for (int j = 0; j < 4; ++j) { const f32x4 g = gr[64 * j]; o8[64 * j] = (unsigned long long)pk2(v[j].x * rstd * g.x, v[j].y * rstd * g.y) | ((unsigned long long)pk2(v[j].z * rstd * g.z, v[j].w * rstd * g.w) << 32); }
}
__device__ __forceinline__ void rms_row_inplace(float* xrow, const float* gain, int lane) {
    f32x4* xr = (f32x4*)xrow + lane; const f32x4* gr = (const f32x4*)gain + lane;
    f32x4 v[4]; float s = 0.f;
#pragma unroll
    for (int j = 0; j < 4; ++j) { v[j] = xr[64 * j]; s += (v[j].x * v[j].x + v[j].y * v[j].y) + (v[j].z * v[j].z + v[j].w * v[j].w); }
    const float rstd = __builtin_amdgcn_rsqf(wave_sum(s) * (1.f / DM) + EPS);
#pragma unroll
    for (int j = 0; j < 4; ++j) { const f32x4 g = gr[64 * j]; xr[64 * j] = v[j] * rstd * g; }
}

template <int KDIM>
__device__ __forceinline__ f32x4 mini_tile(const bf16* A, const bf16* Brow, int wave, int lane) {
    const bf16* ap = A + (size_t)(16 * wave + (lane & 15)) * KDIM + 8 * (lane >> 4);
    const bf16* bp = Brow + 8 * (lane >> 4);
    f32x4 acc = {0.f, 0.f, 0.f, 0.f};
#pragma unroll 8
    for (int k0 = 0; k0 < KDIM; k0 += 32) {
        const bf16x8 a = *(const bf16x8*)(ap + k0), b = *(const bf16x8*)(bp + k0);
        acc = __builtin_amdgcn_mfma_f32_16x16x32_bf16(a, b, acc, 0, 0, 0);
    }
    return acc;
}

namespace hg {
constexpr int QT_OFF = 0, KT_OFF = 64 * 272, KTT_OFF = KT_OFF + 64 * 272, VT_OFF = KTT_OFF + 128 * 144, AM_OFF = VT_OFF + 128 * 144, SEG_OFF = AM_OFF + 64 * 144, SCL_OFF = SEG_OFF + 2048;
__device__ __forceinline__ void h1_unit(unsigned char* lds, int u, const bf16* QS, const float* G, const bf16* VR, bf16* QBg, float* KVT, float* DEC, float* OI, int tid, int wave, int lane) {
    const int bh = u >> 7, c = u & 127, b = bh >> 2, h = bh & 3, row0 = b * SEQ + c * CH, colb = h * 128;
    const int col = tid & 127, seg = tid >> 7;
    unsigned char* QT = lds + QT_OFF; unsigned char* KT = lds + KT_OFF; unsigned char* KTT = lds + KTT_OFF; unsigned char* VT = lds + VT_OFF; unsigned char* AM = lds + AM_OFF;
    float* SEG = (float*)(lds + SEG_OFF); float* SCL = (float*)(lds + SCL_OFF);
    float cs[16]; unsigned short qs[16], vv[16];
    { const size_t base = (size_t)(row0 + seg * 16) * 512 + colb + col;
#pragma unroll
      for (int j = 0; j < 16; ++j) { cs[j] = G[base + (size_t)j * 512]; qs[j] = QS[base + (size_t)j * 512]; vv[j] = VR[base + (size_t)j * 512]; } }
    float gk[16];
#pragma unroll
    for (int j = 0; j < 16; ++j) gk[j] = 1.0f - fexp(cs[j]);
#pragma unroll
    for (int j = 1; j < 16; ++j) cs[j] += cs[j - 1];
    SEG[seg * 128 + col] = cs[15];
    __syncthreads();
    const float t0 = SEG[col], t1 = SEG[128 + col], t2 = SEG[256 + col], t3 = SEG[384 + col];
    const float pre = (seg > 0 ? t0 : 0.f) + (seg > 1 ? t1 : 0.f) + (seg > 2 ? t2 : 0.f);
    const float bref = t0 + t1, blast = (t0 + t1) + (t2 + t3);
    if (seg == 0) { DEC[(size_t)u * 128 + col] = fexp(blast); SCL[col] = fexp(blast - bref); }
    unsigned ktp[8], vtp[8];
#pragma unroll
    for (int j = 0; j < 16; j += 2) {
        float kt2[2];
#pragma unroll
        for (int e = 0; e < 2; ++e) { const int jj = j + e; const float bb = cs[jj] + pre, qv = bf2f(qs[jj]);
            const float qt = qv * fexp(bb - bref), kt = gk[jj] * fexp(bref - bb), qb = qv * fexp(bb);
            const int row = seg * 16 + jj;
            *(unsigned short*)(QT + row * 272 + col * 2) = (unsigned short)f2bf(qt);
            *(unsigned short*)(KT + row * 272 + col * 2) = (unsigned short)f2bf(kt);
            QBg[(size_t)(row0 + row) * 512 + colb + col] = (unsigned short)f2bf(qb);
            kt2[e] = kt; }
        ktp[j >> 1] = pk2(kt2[0], kt2[1]); vtp[j >> 1] = (unsigned)vv[j] | ((unsigned)vv[j + 1] << 16);
    }
    *(v4u*)(KTT + col * 144 + seg * 32) = (v4u){ktp[0], ktp[1], ktp[2], ktp[3]}; *(v4u*)(KTT + col * 144 + seg * 32 + 16) = (v4u){ktp[4], ktp[5], ktp[6], ktp[7]};
    *(v4u*)(VT + col * 144 + seg * 32) = (v4u){vtp[0], vtp[1], vtp[2], vtp[3]}; *(v4u*)(VT + col * 144 + seg * 32 + 16) = (v4u){vtp[4], vtp[5], vtp[6], vtp[7]};
    __syncthreads();
    const int r = lane & 31, hh = lane >> 5;
#pragma unroll
    for (int tt = 0; tt < 2; ++tt) { const int vi = wave >> 1, ki = (wave & 1) * 2 + tt;
        const f32x16 acc = mm32(VT + vi * 32 * 144, 144, KTT + ki * 32 * 144, 144, 4, r, hh);
        const int k = ki * 32 + r; const float sc = SCL[k];
#pragma unroll
        for (int i = 0; i < 16; ++i) { const int v = vi * 32 + crow32(i, hh); KVT[((size_t)u * 128 + v) * 128 + k] = acc[i] * sc; } }
    if (wave < 4) { const int ti = wave >> 1, si = wave & 1;
        const f32x16 acc = mm32(QT + ti * 32 * 272, 272, KT + si * 32 * 272, 272, 8, r, hh);
        const int s = si * 32 + r;
#pragma unroll
        for (int i = 0; i < 16; ++i) { const int t = ti * 32 + crow32(i, hh); *(unsigned short*)(AM + t * 144 + s * 2) = (unsigned short)f2bf(s <= t ? acc[i] : 0.f); } }
    __syncthreads();
    { const int ti = wave >> 2, vi = wave & 3;
        const f32x16 acc = mm32(AM + ti * 32 * 144, 144, VT + vi * 32 * 144, 144, 4, r, hh);
        const int v = vi * 32 + r;
#pragma unroll
        for (int i = 0; i < 16; ++i) { const int t = ti * 32 + crow32(i, hh); OI[(size_t)(row0 + t) * 512 + colb + v] = acc[i]; } }
    __syncthreads();
}
__device__ __forceinline__ void h2_scan(int idx, const float* KVT, const float* DEC, bf16* ST, float* sout) {
    const int bh = idx >> 14, vk = idx & 16383, k = idx & 127, v = (idx >> 7) & 127;
    const float* kv = KVT + (size_t)bh * 128 * 16384 + vk; const float* dc = DEC + (size_t)bh * 128 * 128 + k; bf16* st = ST + (size_t)bh * 128 * 16384 + vk;
    float s = 0.f;
    for (int c0 = 0; c0 < NCH; c0 += 8) {
        float a[8], d[8];
#pragma unroll
        for (int j = 0; j < 8; ++j) { a[j] = kv[(size_t)(c0 + j) * 16384]; d[j] = dc[(c0 + j) * 128]; }
#pragma unroll
        for (int j = 0; j < 8; ++j) { st[(size_t)(c0 + j) * 16384] = (unsigned short)f2bf(s); s = d[j] * s + a[j]; }
    }
    sout[((size_t)bh * 128 + k) * 128 + v] = s;
}
constexpr int QBL_OFF = 0, STL_OFF = 64 * 272, RS_OFF = STL_OFF + 128 * 272;
__device__ __forceinline__ void h3_unit(unsigned char* lds, int u, const bf16* QBg, const bf16* ST, const float* OI, const bf16* GS, const float* rgn, bf16* MRG, int tid, int wave, int lane) {
    const int bh = u >> 7, c = u & 127, b = bh >> 2, h = bh & 3, row0 = b * SEQ + c * CH, colb = h * 128;
    unsigned char* QBL = lds + QBL_OFF; unsigned char* STL = lds + STL_OFF; float* RS = (float*)(lds + RS_OFF);
#pragma unroll
    for (int i = 0; i < 2; ++i) { const int q = tid + 512 * i, row = q >> 4, c16 = q & 15;
        *(v4u*)(QBL + row * 272 + c16 * 16) = *(const v4u*)(QBg + (size_t)(row0 + row) * 512 + colb + c16 * 8); }
#pragma unroll
    for (int i = 0; i < 4; ++i) { const int q = tid + 512 * i, v = q >> 4, c16 = q & 15;
        *(v4u*)(STL + v * 272 + c16 * 16) = *(const v4u*)(ST + ((size_t)u * 128 + v) * 128 + c16 * 8); }
    __syncthreads();
    const int r = lane & 31, hh = lane >> 5, ti = wave >> 2, vi = wave & 3, v = vi * 32 + r;
    const f32x16 acc = mm32(QBL + ti * 32 * 272, 272, STL + vi * 32 * 272, 272, 8, r, hh);
    float o[16];
#pragma unroll
    for (int i = 0; i < 16; ++i) { const int t = ti * 32 + crow32(i, hh); o[i] = acc[i] + OI[(size_t)(row0 + t) * 512 + colb + v];
        float ss = o[i] * o[i];
#pragma unroll
        for (int ofs = 1; ofs < 32; ofs <<= 1) ss += __shfl_xor(ss, ofs);
        if (r == 0) RS[t * 4 + vi] = ss; }
    __syncthreads();
    const float gn = rgn[v];
#pragma unroll
    for (int i = 0; i < 16; ++i) { const int t = ti * 32 + crow32(i, hh);
        const f32x4 p = *(const f32x4*)(RS + t * 4); const float rstd = __builtin_amdgcn_rsqf(((p[0] + p[1]) + (p[2] + p[3])) * (1.0f / 128.0f) + EPS);
        const float gs = bf2f(GS[(size_t)(row0 + t) * 512 + colb + v]);
        MRG[(size_t)(row0 + t) * 1024 + colb + v] = (unsigned short)f2bf(o[i] * rstd * gn * gs); }
    __syncthreads();
}
}

namespace dec {
constexpr int WML_OFF = 0, WO_OFF = 1024, LDS_BYTES = WO_OFF + 8 * 2 * 512 * 4;
__device__ __forceinline__ void partial_unit(unsigned char* lds, int unit, const float* cache_k, const float* cache_v, const int* ptab, const float* PSs, float* PARTML, float* PARTO, int tid, int wave, int lane) {
    const int i = unit >> 4, page = ptab[unit];
    const float* Kp = cache_k + (size_t)page * 65536 + (size_t)(wave * 16) * 512 + 8 * lane;
    const float* Vp = cache_v + (size_t)page * 65536 + (size_t)(wave * 16) * 512 + 8 * lane;
    float* WML = (float*)(lds + WML_OFF); float* WO = (float*)(lds + WO_OFF);
    float q[8];
    { const f32x4 q0 = *(const f32x4*)(PSs + (size_t)i * DIN + 2048 + 8 * lane), q1 = *(const f32x4*)(PSs + (size_t)i * DIN + 2048 + 8 * lane + 4);
#pragma unroll
      for (int e = 0; e < 4; ++e) { q[e] = q0[e] * (0.125f * LOG2E); q[4 + e] = q1[e] * (0.125f * LOG2E); } }
    float s[16];
#define NTL(p) __builtin_nontemporal_load((const f32x4*)(p))
    f32x4 ka[8], kb[8], kc[8], kd[8];
#pragma unroll
    for (int kk = 0; kk < 8; ++kk) { ka[kk] = NTL(Kp + (size_t)kk * 512); kb[kk] = NTL(Kp + (size_t)kk * 512 + 4); }
#pragma unroll
    for (int kk = 0; kk < 8; ++kk) { kc[kk] = NTL(Kp + (size_t)(8 + kk) * 512); kd[kk] = NTL(Kp + (size_t)(8 + kk) * 512 + 4); }
#pragma unroll
    for (int kk = 0; kk < 8; ++kk) {
        float d = (ka[kk][0] * q[0] + ka[kk][1] * q[1]) + (ka[kk][2] * q[2] + ka[kk][3] * q[3]) + (kb[kk][0] * q[4] + kb[kk][1] * q[5]) + (kb[kk][2] * q[6] + kb[kk][3] * q[7]);
        d += __shfl_xor(d, 1); d += __shfl_xor(d, 2); d += __shfl_xor(d, 4);
        s[kk] = d; }
#pragma unroll
    for (int kk = 0; kk < 8; ++kk) { ka[kk] = NTL(Vp + (size_t)kk * 512); kb[kk] = NTL(Vp + (size_t)kk * 512 + 4); }
#pragma unroll
    for (int kk = 0; kk < 8; ++kk) {
        float d = (kc[kk][0] * q[0] + kc[kk][1] * q[1]) + (kc[kk][2] * q[2] + kc[kk][3] * q[3]) + (kd[kk][0] * q[4] + kd[kk][1] * q[5]) + (kd[kk][2] * q[6] + kd[kk][3] * q[7]);
        d += __shfl_xor(d, 1); d += __shfl_xor(d, 2); d += __shfl_xor(d, 4);
        s[8 + kk] = d; }
#pragma unroll
    for (int kk = 0; kk < 8; ++kk) { kc[kk] = NTL(Vp + (size_t)(8 + kk) * 512); kd[kk] = NTL(Vp + (size_t)(8 + kk) * 512 + 4); }
    float mw = s[0];
#pragma unroll
    for (int k = 1; k < 16; ++k) mw = fmaxf(mw, s[k]);
    float lw = 0.f;
#pragma unroll
    for (int k = 0; k < 16; ++k) { s[k] = __builtin_amdgcn_exp2f(s[k] - mw); lw += s[k]; }
    float o0[8], o1[8];
#pragma unroll
    for (int e = 0; e < 8; ++e) { o0[e] = 0.f; o1[e] = 0.f; }
    const int src0 = lane & 48, src1 = (lane & 48) + 8;
#pragma unroll
    for (int kk = 0; kk < 8; ++kk) { const float p0 = __shfl(s[kk], src0), p1 = __shfl(s[kk], src1);
#pragma unroll
        for (int e = 0; e < 4; ++e) { o0[e] += p0 * ka[kk][e]; o0[4 + e] += p0 * kb[kk][e]; o1[e] += p1 * ka[kk][e]; o1[4 + e] += p1 * kb[kk][e]; } }
#pragma unroll
    for (int kk = 0; kk < 8; ++kk) { const float p0 = __shfl(s[8 + kk], src0), p1 = __shfl(s[8 + kk], src1);
#pragma unroll
        for (int e = 0; e < 4; ++e) { o0[e] += p0 * kc[kk][e]; o0[4 + e] += p0 * kd[kk][e]; o1[e] += p1 * kc[kk][e]; o1[4 + e] += p1 * kd[kk][e]; } }
#undef NTL
    if ((lane & 7) == 0) { WML[(wave * 8 + (lane >> 3)) * 2] = mw; WML[(wave * 8 + (lane >> 3)) * 2 + 1] = lw; }
    { float* w0 = WO + (wave * 2 + 0) * 512 + 8 * lane; float* w1 = WO + (wave * 2 + 1) * 512 + 8 * lane;
      *(f32x4*)w0 = (f32x4){o0[0], o0[1], o0[2], o0[3]}; *(f32x4*)(w0 + 4) = (f32x4){o0[4], o0[5], o0[6], o0[7]};
      *(f32x4*)w1 = (f32x4){o1[0], o1[1], o1[2], o1[3]}; *(f32x4*)(w1 + 4) = (f32x4){o1[4], o1[5], o1[6], o1[7]}; }
    __syncthreads();
    { const int h = tid >> 7;
#pragma unroll
      for (int m = 0; m < 2; ++m) { const int hm = 2 * h + m; float M = WML[hm * 2];
#pragma unroll
          for (int w = 1; w < 8; ++w) M = fmaxf(M, WML[(w * 8 + hm) * 2]);
          float L = 0.f, O = 0.f;
#pragma unroll
          for (int w = 0; w < 8; ++w) { const float f = __builtin_amdgcn_exp2f(WML[(w * 8 + hm) * 2] - M); L += f * WML[(w * 8 + hm) * 2 + 1]; O += f * WO[(w * 2 + m) * 512 + tid]; }
          PARTO[((size_t)unit * 2 + m) * 512 + tid] = O;
          if ((tid & 127) == 0) { PARTML[((size_t)unit * 8 + hm) * 2] = M; PARTML[((size_t)unit * 8 + hm) * 2 + 1] = L; } } }
    __syncthreads();
}
__device__ __forceinline__ void combine_item(unsigned char* lds, int i, const float* PSs, const float* PARTML, const float* PARTO, const float* subln, float lam, bf16* MRGs, int tid, int wave, int lane) {
    float* CW = (float*)lds;
    float* SSQ = (float*)(lds + 1024);
    { const int hm = wave;
      const float qv = PSs[(size_t)i * DIN + 2048 + hm * 64 + lane] * (0.125f * LOG2E), kn = PSs[(size_t)i * DIN + 2560 + hm * 64 + lane];
      const float sn = wave_sum(qv * kn);
      float Mj = -1e30f, Lj = 0.f;
      if (lane < 16) { Mj = PARTML[(((size_t)i * 16 + lane) * 8 + hm) * 2]; Lj = PARTML[(((size_t)i * 16 + lane) * 8 + hm) * 2 + 1]; }
      const float M = fmaxf(wave_max(Mj), sn);
      const float wj = (lane < 16) ? __builtin_amdgcn_exp2f(Mj - M) : 0.f, wn = __builtin_amdgcn_exp2f(sn - M);
      const float Lt = wave_sum(wj * Lj) + wn, inv = 1.0f / Lt;
      if (lane < 16) CW[hm * 17 + lane] = wj * inv;
      if (lane == 16) CW[hm * 17 + 16] = wn * inv; }
    __syncthreads();
    const int h = tid >> 7;
    float om[2];
#pragma unroll
    for (int m = 0; m < 2; ++m) { const int hm = 2 * h + m; float a = CW[hm * 17 + 16] * PSs[(size_t)i * DIN + 3072 + tid];
#pragma unroll
        for (int j = 0; j < 16; ++j) a += CW[hm * 17 + j] * PARTO[(((size_t)i * 16 + j) * 2 + m) * 512 + tid];
        om[m] = a; }
    const float a = om[0] - lam * om[1];
    const float ssw = wave_sum(a * a);
    if (lane == 0) SSQ[wave] = ssw;
    __syncthreads();
    const float ss = SSQ[2 * h] + SSQ[2 * h + 1];
    const float rstd = __builtin_amdgcn_rsqf(ss * (1.0f / 128.0f) + EPS);
    MRGs[(size_t)i * 1024 + 512 + tid] = (unsigned short)f2bf(a * rstd * subln[tid & 127] * (1.0f - LAM_INIT));
    __syncthreads();
}
__device__ __forceinline__ void recurrent_unit(unsigned char* lds, int unit, const float* PSs, const float* state, const float* lbp, const float* rgn, float* sout, bf16* MRGs, int tid, int wave, int lane) {
    const int i = unit >> 2, h = unit & 3;
    float* RO = (float*)lds;
    float* SSQ = (float*)(lds + 8192);
    const int v4 = (tid & 31) * 4, ks = tid >> 5;
    const float* ps = PSs + (size_t)i * DIN;
    const f32x4 vv = *(const f32x4*)(ps + 1024 + h * 128 + v4);
    const float* sp = state + ((size_t)unit * 128) * 128 + v4; float* so = sout + ((size_t)unit * 128) * 128 + v4;
    f32x4 po = {0.f, 0.f, 0.f, 0.f};
    f32x4 sold[8];
#pragma unroll
    for (int jj = 0; jj < 8; ++jj) sold[jj] = *(const f32x4*)(sp + (size_t)(ks + 16 * jj) * 128);
#pragma unroll
    for (int jj = 0; jj < 8; ++jj) { const int k = ks + 16 * jj, kc = h * 128 + k;
        const float lb = sigm(lbp[kc] - lbp[512 + kc]); const float f = lb + (1.0f - lb) * sigm(ps[512 + kc]); const float kk = 1.0f - f, qk = siluf(ps[kc]);
        const f32x4 sn = sold[jj] * f + vv * kk; *(f32x4*)(so + (size_t)k * 128) = sn; po += sn * qk; }
    *(f32x4*)(RO + ks * 128 + v4) = po;
    __syncthreads();
    float o = 0.f;
    if (tid < 128) {
#pragma unroll
        for (int j = 0; j < 16; ++j) o += RO[j * 128 + tid];
        const float ssw = wave_sum(o * o); if (lane == 0) SSQ[wave] = ssw; }
    __syncthreads();
    if (tid < 128) { const float rstd = __builtin_amdgcn_rsqf((SSQ[0] + SSQ[1]) * (1.0f / 128.0f) + EPS);
        MRGs[(size_t)i * 1024 + h * 128 + tid] = (unsigned short)f2bf(o * rstd * rgn[tid] * siluf(ps[1536 + h * 128 + tid])); }
    __syncthreads();
}
}
#ifndef MK_N_LAUNCHES
#define MK_N_LAUNCHES 1
#endif
constexpr int N_PHASES = 9;
constexpr int N_LAUNCHES = MK_N_LAUNCHES;
static_assert(N_LAUNCHES == 1 || N_LAUNCHES == N_PHASES, "MK_N_LAUNCHES is 1 or 9");
constexpr size_t MiB = 1u << 20;
constexpr size_t WS_CTL = 0, CTL_ZERO_BYTES = 1 * MiB;
constexpr size_t WS_WIN = 2 * MiB;
constexpr size_t WS_WOUT = 10 * MiB;
constexpr size_t WS_WGU = 12 * MiB;
constexpr size_t WS_WD = 24 * MiB;
constexpr size_t WS_PSS = 30 * MiB;
constexpr size_t WS_PS1 = 32 * MiB;
constexpr size_t WS_PS1S = 33 * MiB;
constexpr size_t WS_DEC = 34 * MiB;
constexpr size_t WS_PML = 35 * MiB;
constexpr size_t WS_PO = 36 * MiB;
constexpr size_t WS_XN = 48 * MiB;
constexpr size_t WS_QS = 96 * MiB, WS_VR = 112 * MiB, WS_GS = 128 * MiB, WS_QA = 144 * MiB, WS_KA = 160 * MiB, WS_VA = 176 * MiB;
constexpr size_t WS_G = 192 * MiB;
constexpr size_t WS_QB = 224 * MiB;
constexpr size_t WS_OI = 240 * MiB;
constexpr size_t WS_KVT = 272 * MiB;
constexpr size_t WS_ST = 336 * MiB;
constexpr size_t WS_MRG = 368 * MiB;
constexpr size_t WS_X1 = 416 * MiB;
constexpr size_t WS_XB = 496 * MiB;
constexpr size_t WS_H = 544 * MiB;
constexpr size_t WS_END = 640 * MiB;
constexpr int CW_TMO = 0, CW_BAR = 4096;
constexpr size_t O_Y = 0, O_YS = (size_t)MP * DM, O_KP = O_YS + (size_t)MS * DM, O_VP = O_KP + (size_t)MP * 512, O_SP = O_VP + (size_t)MP * 512,
                 O_KS = O_SP + 8 * 16384, O_VS = O_KS + (size_t)MS * 512, O_SS = O_VS + (size_t)MS * 512, O_END = O_SS + (size_t)MS * 4 * 16384;
constexpr int RING_OFF = 0, RING_BYTES = 143360;
constexpr int LDSCTL_OFF = RING_BYTES, MISC_OFF = LDSCTL_OFF + 320;
constexpr int LDS_BYTES = 147456;
static_assert(att::LDS_BYTES <= RING_BYTES && MISC_OFF + 128 <= LDS_BYTES, "LDS map");

struct Args { const float* in[21]; const int* ptab; float* out; unsigned char* ws; int ph_lo, ph_hi; };

__global__ void __launch_bounds__(NWAVES * 64, 2) mk_fwd(Args args) {
    extern __shared__ __attribute__((aligned(16))) unsigned char lds[];
    const int tid = threadIdx.x, lane = tid & 63, wave = __builtin_amdgcn_readfirstlane(tid >> 6);
    const int G = gridDim.x, bx = blockIdx.x;
    volatile LAS unsigned* MISC = (volatile LAS unsigned*)((LAS unsigned char*)lds + MISC_OFF);
    unsigned char* ws = args.ws;
    gu32* ctl = (gu32*)(ws + WS_CTL);
    for (int u = tid; u < (LDS_BYTES - LDSCTL_OFF) / 4; u += NWAVES * 64) ((LAS unsigned*)((LAS unsigned char*)lds + LDSCTL_OFF))[u] = 0u;
    __syncthreads();
    XcdBarrier bar; bar.bar = (unsigned*)(ctl + CW_BAR); bar.x = 0; bar.st = nullptr;
    if (N_LAUNCHES == 1) bar = xcd_barrier_post((unsigned*)(ctl + CW_BAR), MISC + 8);
#ifndef BAR_REPS
#define BAR_REPS 1
#endif
#define GRID_BAR() do { if (N_LAUNCHES == 1) { for (int br_ = 0; br_ < BAR_REPS; ++br_) xcd_barrier(bar); } } while (0)
    const int lo = args.ph_lo, hi = args.ph_hi;
#ifndef PHASE_MASK
#define PHASE_MASK 0x1ff
#endif
#define IN(k) (((PHASE_MASK >> (k)) & 1) && lo <= (k) && (k) < hi)
#define BOTH(k) (IN(k) && IN((k) + 1))
#ifndef DBL_MASK
#define DBL_MASK 0
#endif
#define NREP(k) (((DBL_MASK >> (k)) & 1) ? 2 : 1)
    const float* x_p = args.in[0]; const float* x_s = args.in[1]; const float* cache_k = args.in[2]; const float* cache_v = args.in[3]; const float* state = args.in[4];
    const float* w_in = args.in[6]; const float* w_out = args.in[7]; const float* lbp = args.in[8]; const float* rgn = args.in[9];
    const float* lq1 = args.in[10]; const float* lk1 = args.in[11]; const float* lq2 = args.in[12]; const float* lk2 = args.in[13]; const float* subln = args.in[14];
    const float* n_mix = args.in[15]; const float* n_ffn = args.in[16]; const float* w_gate = args.in[17]; const float* w_up = args.in[18]; const float* w_down = args.in[19]; const float* n_fin = args.in[20];
    const int* ptab = args.ptab; float* out = args.out;
    bf16* Win_t = (bf16*)(ws + WS_WIN); bf16* Wout_t = (bf16*)(ws + WS_WOUT); bf16* Wgu_t = (bf16*)(ws + WS_WGU); bf16* Wd_t = (bf16*)(ws + WS_WD);
    float* PSs = (float*)(ws + WS_PSS); float* PS1 = (float*)(ws + WS_PS1); float* PS1s = (float*)(ws + WS_PS1S); float* DEC = (float*)(ws + WS_DEC);
    float* PML = (float*)(ws + WS_PML); float* PO = (float*)(ws + WS_PO);
    bf16* XN = (bf16*)(ws + WS_XN); bf16* QS = (bf16*)(ws + WS_QS); bf16* VR = (bf16*)(ws + WS_VR); bf16* GS = (bf16*)(ws + WS_GS);
    bf16* QA = (bf16*)(ws + WS_QA); bf16* KA = (bf16*)(ws + WS_KA); bf16* VA = (bf16*)(ws + WS_VA); float* Gl = (float*)(ws + WS_G);
    bf16* QBg = (bf16*)(ws + WS_QB); float* OI = (float*)(ws + WS_OI); float* KVT = (float*)(ws + WS_KVT); bf16* ST = (bf16*)(ws + WS_ST);
    bf16* MRG = (bf16*)(ws + WS_MRG); float* X1 = (float*)(ws + WS_X1); bf16* XB = (bf16*)(ws + WS_XB); bf16* Hb = (bf16*)(ws + WS_H);

    if (IN(0)) { _Pragma("unroll") for (int rep = 0; rep < NREP(0); ++rep) {
        float* scr = (float*)(lds + RING_OFF + wave * 16384);
        const int gw = bx * NWAVES + wave, NGW = G * NWAVES;
        constexpr int I_IN = (DM / 64) * (DIN / 32), I_OUT = (DM / 64) * (DM / 32), I_G = (DM / 64) * (DFF / 32), I_D = (DFF / 64) * (DM / 32);
        constexpr int NITEMS = I_IN + I_OUT + 2 * I_G + I_D;
        for (int it = gw; it < NITEMS; it += NGW) {
            int r = it;
            if (r < I_IN) { p0_transpose_item<0>(w_in, DM, DIN, Win_t, nullptr, scr, r, lane); continue; } r -= I_IN;
            if (r < I_OUT) { p0_transpose_item<0>(w_out, DM, DM, Wout_t, nullptr, scr, r, lane); continue; } r -= I_OUT;
            if (r < I_G) { p0_transpose_item<1>(w_gate, DM, DFF, Wgu_t, n_ffn, scr, r, lane); continue; } r -= I_G;
            if (r < I_G) { p0_transpose_item<2>(w_up, DM, DFF, Wgu_t, n_ffn, scr, r, lane); continue; } r -= I_G;
            p0_transpose_item<0>(w_down, DFF, DM, Wd_t, nullptr, scr, r, lane);
        }
        for (int m = gw; m < MT; m += NGW) rms_row_to_bf16(m < MP ? x_p + (size_t)m * DM : x_s + (size_t)(m - MP) * DM, n_mix, XN + (size_t)m * DM, lane);
        __syncthreads(); }
        if (BOTH(0)) GRID_BAR();
    }
    if (IN(1)) { _Pragma("unroll") for (int rep = 0; rep < NREP(1); ++rep) {
        { pg8::Gemm g{XN, Win_t, MP, DIN, DM}; pg8::StaticOrder S; S.init(MP, DIN, G, bx);
          pg8::EpiInProj E{QS, VR, GS, QA, KA, VA, Gl, out + O_KP, out + O_VP, lbp};
          pg8::gemm_phase<pg8::EpiInProj, pg8::StaticOrder, true, true>((LAS unsigned char*)lds + RING_OFF, g, S, E); }
        if (bx >= G / 2) {
            for (int t = bx - G / 2; t < DIN / 16; t += G / 2) { const int n0 = t * 16;
                const f32x4 acc = mini_tile<DM>(XN + (size_t)MP * DM, Win_t + (size_t)(n0 + (lane & 15)) * DM, wave, lane);
                const int c = lane & 15, q = lane >> 4;
#pragma unroll
                for (int i = 0; i < 4; ++i) { const int row = 16 * wave + 4 * q + i; const float v = acc[i];
                    PSs[(size_t)row * DIN + n0 + c] = v;
                    if (n0 >= 2560 && n0 < 3072) out[O_KS + (size_t)row * 512 + (n0 - 2560) + c] = v;
                    if (n0 >= 3072) out[O_VS + (size_t)row * 512 + (n0 - 3072) + c] = v; } }
        } }
        if (BOTH(1)) GRID_BAR();
    }
    if (IN(2)) {
        for (int rep = 0; rep < NREP(9); ++rep) for (int u = bx; u < NHU; u += G) hg::h1_unit(lds + RING_OFF, u, QS, Gl, VR, QBg, KVT, DEC, OI, tid, wave, lane);
        __syncthreads();
        { att::Consts C; const float s1 = wave_sum(lq1[lane] * lk1[lane]), s2 = wave_sum(lq2[lane] * lk2[lane]);
          C.lam = __builtin_bit_cast(float, __builtin_amdgcn_readfirstlane(__builtin_bit_cast(int, fexp(s1) - fexp(s2) + LAM_INIT))); C.oscale = 1.0f - LAM_INIT; C.subln = subln;
          if ((bx & 7) < 4) { for (int rep = 0; rep < NREP(11); ++rep) for (int u = bx; u < MS * NPAGES; u += G) dec::partial_unit(lds + RING_OFF, u, cache_k, cache_v, ptab, PSs, PML, PO, tid, wave, lane); }
          att::attn_phase((char*)lds + RING_OFF, QA, KA, VA, MRG, C, G, bx);
          __syncthreads();
          if ((bx & 7) >= 4) { for (int rep = 0; rep < NREP(11); ++rep) for (int u = bx; u < MS * NPAGES; u += G) dec::partial_unit(lds + RING_OFF, u, cache_k, cache_v, ptab, PSs, PML, PO, tid, wave, lane); } }
        if (BOTH(2)) GRID_BAR();
    }
    if (IN(3)) { _Pragma("unroll") for (int rep = 0; rep < NREP(3); ++rep) {
        for (int idx = bx * 512 + tid; idx < 8 * 16384; idx += G * 512) hg::h2_scan(idx, KVT, DEC, ST, out + O_SP);
        { const float s1 = wave_sum(lq1[lane] * lk1[lane]), s2 = wave_sum(lq2[lane] * lk2[lane]); const float lam = fexp(s1) - fexp(s2) + LAM_INIT;
          for (int i = bx; i < MS; i += G) dec::combine_item(lds + RING_OFF, i, PSs, PML, PO, subln, lam, MRG + (size_t)MP * DM, tid, wave, lane); }
        for (int u = bx; u < MS * 4; u += G) dec::recurrent_unit(lds + RING_OFF, u, PSs, state, lbp, rgn, out + O_SS, MRG + (size_t)MP * DM, tid, wave, lane); }
        if (BOTH(3)) GRID_BAR();
    }
    if (IN(4)) {
        for (int rep = 0; rep < NREP(4); ++rep) for (int u = bx; u < NHU; u += G) hg::h3_unit(lds + RING_OFF, u, QBg, ST, OI, GS, rgn, MRG, tid, wave, lane);
        if (BOTH(4)) GRID_BAR();
    }
    if (IN(5)) { _Pragma("unroll") for (int rep = 0; rep < NREP(5); ++rep) {
        { pg8::Gemm g{MRG, Wout_t, MP, DM, DM}; pg8::StaticOrder S; S.init(MP, DM, G, bx);
          pg8::EpiWout E{x_p, X1, XB, PS1};
          pg8::gemm_phase<pg8::EpiWout, pg8::StaticOrder, true, true>((LAS unsigned char*)lds + RING_OFF, g, S, E); }
        for (int t = bx; t < DM / 16; t += G) { const int n0 = t * 16;
            const f32x4 acc = mini_tile<DM>(MRG + (size_t)MP * DM, Wout_t + (size_t)(n0 + (lane & 15)) * DM, wave, lane);
            const int c = lane & 15, q = lane >> 4;
#pragma unroll
            for (int i = 0; i < 4; ++i) { const int row = 16 * wave + 4 * q + i; const float v = x_s[(size_t)row * DM + n0 + c] + acc[i];
                X1[(size_t)(MP + row) * DM + n0 + c] = v; XB[(size_t)(MP + row) * DM + n0 + c] = (unsigned short)f2bf(v);
                float ss = v * v; ss += __shfl_xor(ss, 1); ss += __shfl_xor(ss, 2); ss += __shfl_xor(ss, 4); ss += __shfl_xor(ss, 8);
                if (c == 0) PS1s[row * 64 + t] = ss; } } }
        if (BOTH(5)) GRID_BAR();
    }
    if (IN(6)) { _Pragma("unroll") for (int rep = 0; rep < NREP(6); ++rep) {
        { pg8::Gemm g{XB, Wgu_t, MP, NGU, DM}; pg8::StaticOrder S; S.init(MP, NGU, G, bx);
          pg8::EpiGateUp E{PS1, Hb};
          pg8::gemm_phase<pg8::EpiGateUp, pg8::StaticOrder, true, true>((LAS unsigned char*)lds + RING_OFF, g, S, E); }
        if (bx >= G / 2) {
            float* RSTD = (float*)(lds + RING_OFF);
            if (tid < MS) { float s = 0.f;
#pragma unroll
                for (int j = 0; j < 16; ++j) { const f32x4 p = *(const f32x4*)(PS1s + tid * 64 + 4 * j); s += (p[0] + p[1]) + (p[2] + p[3]); }
                RSTD[tid] = __builtin_amdgcn_rsqf(s * (1.0f / 1024.0f) + EPS); }
            __syncthreads();
            for (int t = bx - G / 2; t < DFF / 16; t += G / 2) { const int f0 = t * 16, f = f0 + (lane & 15), grow = (f >> 2) * 8 + (f & 3);
                const f32x4 ag = mini_tile<DM>(XB + (size_t)MP * DM, Wgu_t + (size_t)grow * DM, wave, lane);
                const f32x4 au = mini_tile<DM>(XB + (size_t)MP * DM, Wgu_t + (size_t)(grow + 4) * DM, wave, lane);
                const int c = lane & 15, q = lane >> 4;
#pragma unroll
                for (int i = 0; i < 4; ++i) { const int row = 16 * wave + 4 * q + i; const float rs = RSTD[row];
                    Hb[(size_t)(MP + row) * DFF + f0 + c] = (unsigned short)f2bf(siluf(ag[i] * rs) * (au[i] * rs)); } }
            __syncthreads();
        } }
        if (BOTH(6)) GRID_BAR();
    }
    if (IN(7)) { _Pragma("unroll") for (int rep = 0; rep < NREP(7); ++rep) {
        { pg8::Gemm g{Hb, Wd_t, MP, DM, DFF}; pg8::StaticOrder S; S.init(MP, DM, G, bx);
          pg8::EpiDown E{X1, out + O_Y};
          pg8::gemm_phase<pg8::EpiDown, pg8::StaticOrder, true, true>((LAS unsigned char*)lds + RING_OFF, g, S, E); }
        for (int t = bx; t < DM / 16; t += G) { const int n0 = t * 16;
            const f32x4 acc = mini_tile<DFF>(Hb + (size_t)MP * DFF, Wd_t + (size_t)(n0 + (lane & 15)) * DFF, wave, lane);
            const int c = lane & 15, q = lane >> 4;
#pragma unroll
            for (int i = 0; i < 4; ++i) { const int row = 16 * wave + 4 * q + i;
                out[O_YS + (size_t)row * DM + n0 + c] = X1[(size_t)(MP + row) * DM + n0 + c] + acc[i]; } } }
        if (BOTH(7)) GRID_BAR();
    }
    if (IN(8)) {
        const int gw = bx * NWAVES + wave, NGW = G * NWAVES;
        for (int m = gw; m < MT; m += NGW) rms_row_inplace(m < MP ? out + O_Y + (size_t)m * DM : out + O_YS + (size_t)(m - MP) * DM, n_fin, lane);
    }
#undef IN
#undef BOTH
#undef GRID_BAR
}

extern "C" void kernel_launch(void* const* d_in, const int* in_sizes, int n_in, void* d_out, int out_size, void* d_ws, size_t ws_size, hipStream_t stream) {
    static int grid = 0;
    if (grid == 0) {
        if (n_in != 21 || in_sizes[0] != MP * DM || (size_t)out_size != O_END || ws_size < WS_END) {
            fprintf(stderr, "kernel_launch: unexpected shapes (n_in %d, in0 %d, out %d, ws %zu); nothing launched\n", n_in, n_in > 0 ? in_sizes[0] : -1, out_size, ws_size); grid = -1; return; }
        int dev = 0, cus = 0, per_cu = 0;
        if (hipGetDevice(&dev) != hipSuccess || hipDeviceGetAttribute(&cus, hipDeviceAttributeMultiprocessorCount, dev) != hipSuccess) { grid = -1; return; }
        if (hipFuncSetAttribute((const void*)mk_fwd, hipFuncAttributeMaxDynamicSharedMemorySize, LDS_BYTES) != hipSuccess) { fprintf(stderr, "kernel_launch: hipFuncSetAttribute failed\n"); grid = -1; return; }
        if (hipOccupancyMaxActiveBlocksPerMultiprocessor(&per_cu, (const void*)mk_fwd, NWAVES * 64, LDS_BYTES) != hipSuccess || per_cu < 1)
            fprintf(stderr, "kernel_launch: note: occupancy query reports %d workgroups per CU\n", per_cu);
        (void)hipGetLastError();
        grid = cus;
        if (grid > 256) grid = 256;
        grid &= ~7;
    }
    if (grid <= 0) return;
    (void)hipMemsetAsync((char*)d_ws + WS_CTL, 0, CTL_ZERO_BYTES, stream);
    Args a{};
    for (int i = 0; i < 21; ++i) a.in[i] = (const float*)d_in[i];
    a.ptab = (const int*)d_in[5]; a.out = (float*)d_out; a.ws = (unsigned char*)d_ws;
    if (N_LAUNCHES == 1) { a.ph_lo = 0; a.ph_hi = N_PHASES; hipLaunchKernelGGL(mk_fwd, dim3(grid), dim3(NWAVES * 64), LDS_BYTES, stream, a); }
    else for (int p = 0; p < N_PHASES; ++p) { a.ph_lo = p; a.ph_hi = p + 1; hipLaunchKernelGGL(mk_fwd, dim3(grid), dim3(NWAVES * 64), LDS_BYTES, stream, a); }
    const hipError_t le = hipPeekAtLastError();
    if (le != hipSuccess) fprintf(stderr, "kernel_launch: launch failed: %s\n", hipGetErrorName(le));
}
```

```cpp
#include <hip/hip_runtime.h>
#include <hip/hip_bf16.h>
#include <cstdio>
#include <cstdint>

constexpr int DM = 1024, NBATCH = 2, SEQ = 8192, MP = NBATCH * SEQ, MS = 128, MT = MP + MS;
constexpr int DIN = 3584, DFF = 2816, NGU = 2 * DFF;
constexpr int NPAGES = 16, PAGE = 128;
constexpr int CH = 64, NCH = SEQ / CH, NHU = NBATCH * 4 * NCH;
constexpr float EPS = 1e-6f;
constexpr float LOG2E = 1.4426950408889634f, LN2 = 0.6931471805599453f;
constexpr float LAM_INIT = 0.2f;

#define GAS __attribute__((address_space(1)))
#define LAS __attribute__((address_space(3)))
typedef unsigned short bf16;
typedef unsigned v4u __attribute__((ext_vector_type(4)));
typedef unsigned v2u __attribute__((ext_vector_type(2)));
typedef float f32x4 __attribute__((ext_vector_type(4)));
typedef float f32x16 __attribute__((ext_vector_type(16)));
typedef short bf16x8 __attribute__((ext_vector_type(8)));
typedef GAS unsigned gu32;
#define RLX_AGENT __ATOMIC_RELAXED, __HIP_MEMORY_SCOPE_AGENT
#define LDS_WAIT() asm volatile("s_waitcnt lgkmcnt(0)" ::: "memory")
#define VM_WAIT() asm volatile("s_waitcnt vmcnt(0)" ::: "memory")
__device__ __forceinline__ unsigned f2bf(float f) { unsigned u = __builtin_bit_cast(unsigned, f); return (u + 0x7fffu + ((u >> 16) & 1u)) >> 16; }
__device__ __forceinline__ unsigned pk2(float lo, float hi) { return f2bf(lo) | (f2bf(hi) << 16); }
__device__ __forceinline__ float bf2f(unsigned short b) { return __builtin_bit_cast(float, (unsigned)b << 16); }
__device__ __forceinline__ float sigm(float x) { return __builtin_amdgcn_rcpf(1.0f + __builtin_amdgcn_exp2f(-LOG2E * x)); }
__device__ __forceinline__ float siluf(float x) { return x * sigm(x); }
__device__ __forceinline__ float fexp(float x) { return __builtin_amdgcn_exp2f(LOG2E * x); }
__device__ __forceinline__ float wave_sum(float v) {
#pragma unroll
    for (int o = 1; o < 64; o <<= 1) v += __shfl_xor(v, o);
    return v;
}
__device__ __forceinline__ float wave_max(float v) {
#pragma unroll
    for (int o = 1; o < 64; o <<= 1) v = fmaxf(v, __shfl_xor(v, o));
    return v;
}
namespace pg8 {
#define PG8_LAS __attribute__((address_space(3)))
typedef unsigned short bf16_t;
typedef short bf16x8 __attribute__((ext_vector_type(8)));
typedef float f32x4 __attribute__((ext_vector_type(4)));
typedef unsigned u32x4 __attribute__((ext_vector_type(4)));
constexpr int BM = 256, BK = 64, HALF = 128, HTB = HALF * BK * 2  , STAGE_BYTES = 8 * HTB, NXCD = 8, WGM = 8;

__host__ __device__ __forceinline__ int lds_byte(int r, int c) { const int st = (r >> 4) * 2 + (c >> 5), rr = r & 15, cc = c & 31, ob = rr * 64 + cc * 2; return st * 1024 + (ob ^ (((ob >> 9) & 1) << 5)); }
__host__ __device__ __forceinline__ void stage_rc(int b, int& R, int& C) { const int st = b / 1024, sb = b % 1024, swz = sb ^ (((sb >> 9) & 1) << 5); R = (st >> 1) * 16 + swz / 64; C = (st & 1) * 32 + (swz % 64) / 2; }
__host__ __device__ __forceinline__ int perm32(int rho) { const int n = rho >> 4, i = rho & 15; return 8 * (i >> 2) + 4 * n + (i & 3); }

struct Unit { int pm, pn; };
struct Gemm { const bf16_t* A; const bf16_t* Bt; int M, N, K; };

struct StaticOrder {
    int nM, nN, nwg, G, c;
    __host__ __device__ void init(int M, int N, int G_, int c_) { nM = M / BM; nN = N / BM; nwg = nM * nN; G = G_; c = c_; }
    __host__ __device__ bool next(int i, Unit& u) const {
        const long L = (long)i * G + c; if (L >= nwg) return false;
        int wgid = (int)L; { const int q = nwg / NXCD, r = nwg % NXCD, xcd = wgid % NXCD, off = wgid / NXCD; wgid = (xcd < r ? xcd * (q + 1) : r * (q + 1) + (xcd - r) * q) + off; }
        const int nig = WGM * nN, gid = wgid / nig, fm = gid * WGM, gsz = (nM - fm) < WGM ? (nM - fm) : WGM;
        u.pm = fm + ((wgid % nig) % gsz); u.pn = (wgid % nig) / gsz; return true;
    }
    __device__ __forceinline__ void a_ready(const Unit&) const {}
    __device__ __forceinline__ void done(const Unit&) const {}
};

__device__ __forceinline__ unsigned cvt_pk_bf16(float lo, float hi) { unsigned r; asm volatile("v_cvt_pk_bf16_f32 %0, %1, %2" : "=v"(r) : "v"(lo), "v"(hi)); return r; }
typedef float f32x2 __attribute__((ext_vector_type(2)));
typedef unsigned u32x2 __attribute__((ext_vector_type(2)));
struct EpiInProj {
    static constexpr bool PERM = true, AFTER_DRAIN = false;
    bf16_t *QS, *VR, *GS, *QA, *KA, *VA; float* G; float* kout; float* vout; const float* lbp;
    __device__ __forceinline__ void operator()(const f32x4 (&acc)[2][2][4][2], const Unit& u, int wr, int wc, int fr, int fq) const {
        const int grp = u.pn >> 1;
        const int cb = (u.pn & 1) * 256 + wc * 32 + 8 * fq;
        const int row0 = u.pm * BM + wr * 64 + fr;
        if (grp == 1) {
            float lb[2][8];
#pragma unroll
            for (int bj = 0; bj < 2; ++bj)
#pragma unroll
                for (int e = 0; e < 8; ++e) { const int c = cb + bj * HALF + e; lb[bj][e] = ::sigm(lbp[c] - lbp[512 + c]); }
#pragma unroll
            for (int ai = 0; ai < 2; ++ai)
#pragma unroll
                for (int m = 0; m < 4; ++m) { const size_t row = (size_t)(row0 + ai * HALF + m * 16);
#pragma unroll
                    for (int bj = 0; bj < 2; ++bj) { const f32x4 v0 = acc[ai][bj][m][0], v1 = acc[ai][bj][m][1]; f32x4 g0, g1;
#pragma unroll
                        for (int e = 0; e < 4; ++e) { const float f0 = lb[bj][e] + (1.0f - lb[bj][e]) * ::sigm(v0[e]), f1 = lb[bj][4 + e] + (1.0f - lb[bj][4 + e]) * ::sigm(v1[e]);
                            g0[e] = __builtin_amdgcn_logf(f0) * LN2; g1[e] = __builtin_amdgcn_logf(f1) * LN2; }
                        float* gp = G + row * 512 + cb + bj * HALF; *(f32x4*)gp = g0; *(f32x4*)(gp + 4) = g1; } }
        } else {
            bf16_t* dst = grp == 0 ? QS : grp == 2 ? VR : grp == 3 ? GS : grp == 4 ? QA : grp == 5 ? KA : VA;
            float* fo = grp == 5 ? kout : grp == 6 ? vout : nullptr;
            const bool act = (grp == 0 || grp == 3);
#pragma unroll
            for (int ai = 0; ai < 2; ++ai)
#pragma unroll
                for (int m = 0; m < 4; ++m) { const size_t row = (size_t)(row0 + ai * HALF + m * 16);
#pragma unroll
                    for (int bj = 0; bj < 2; ++bj) { f32x4 v0 = acc[ai][bj][m][0], v1 = acc[ai][bj][m][1];
                        const size_t off = row * 512 + cb + bj * HALF;
                        if (fo) { *(f32x4*)(fo + off) = v0; *(f32x4*)(fo + off + 4) = v1; }
                        if (act) {
#pragma unroll
                            for (int e = 0; e < 4; ++e) { v0[e] = ::siluf(v0[e]); v1[e] = ::siluf(v1[e]); } }
                        u32x4 w; w.x = cvt_pk_bf16(v0[0], v0[1]); w.y = cvt_pk_bf16(v0[2], v0[3]); w.z = cvt_pk_bf16(v1[0], v1[1]); w.w = cvt_pk_bf16(v1[2], v1[3]);
                        *(u32x4*)(dst + off) = w; } }
        }
    }
};
struct EpiWout {
    static constexpr bool PERM = false, AFTER_DRAIN = false;
    const float* X; float* X1; bf16_t* XB; float* PS1;
    __device__ __forceinline__ void operator()(const f32x4 (&acc)[2][2][4][2], const Unit& u, int wr, int wc, int fr, int fq) const {
        const int row0 = u.pm * BM + wr * 64 + fr, col0 = u.pn * BM + wc * 32 + 4 * fq;
#pragma unroll
        for (int ai = 0; ai < 2; ++ai)
#pragma unroll
            for (int m = 0; m < 4; ++m) { const size_t row = (size_t)(row0 + ai * HALF + m * 16); float ss = 0.f;
#pragma unroll
                for (int bj = 0; bj < 2; ++bj)
#pragma unroll
                    for (int n = 0; n < 2; ++n) { const size_t off = row * 1024 + col0 + bj * HALF + n * 16;
                        const f32x4 v = *(const f32x4*)(X + off) + acc[ai][bj][m][n]; *(f32x4*)(X1 + off) = v;
                        u32x2 w; w.x = cvt_pk_bf16(v[0], v[1]); w.y = cvt_pk_bf16(v[2], v[3]); *(u32x2*)(XB + off) = w;
                        ss += (v[0] * v[0] + v[1] * v[1]) + (v[2] * v[2] + v[3] * v[3]); }
                ss += __shfl_xor(ss, 16); ss += __shfl_xor(ss, 32);
                if (fq == 0) PS1[row * 16 + u.pn * 4 + wc] = ss; }
    }
};
struct EpiGateUp {
    static constexpr bool PERM = true, AFTER_DRAIN = false;
    const float* PS1; bf16_t* H;
    __device__ __forceinline__ void operator()(const f32x4 (&acc)[2][2][4][2], const Unit& u, int wr, int wc, int fr, int fq) const {
        const int row0 = u.pm * BM + wr * 64 + fr, f0 = (u.pn * BM + wc * 32 + 8 * fq) >> 1;
#pragma unroll
        for (int ai = 0; ai < 2; ++ai)
#pragma unroll
            for (int m = 0; m < 4; ++m) { const size_t row = (size_t)(row0 + ai * HALF + m * 16);
                const f32x4 p0 = *(const f32x4*)(PS1 + row * 16), p1 = *(const f32x4*)(PS1 + row * 16 + 4), p2 = *(const f32x4*)(PS1 + row * 16 + 8), p3 = *(const f32x4*)(PS1 + row * 16 + 12);
                const f32x4 ps = (p0 + p1) + (p2 + p3);
                const float rstd = __builtin_amdgcn_rsqf(((ps[0] + ps[1]) + (ps[2] + ps[3])) * (1.0f / 1024.0f) + EPS);
#pragma unroll
                for (int bj = 0; bj < 2; ++bj) { const f32x4 g = acc[ai][bj][m][0] * rstd, uu = acc[ai][bj][m][1] * rstd;
                    u32x2 w; w.x = cvt_pk_bf16(::siluf(g[0]) * uu[0], ::siluf(g[1]) * uu[1]); w.y = cvt_pk_bf16(::siluf(g[2]) * uu[2], ::siluf(g[3]) * uu[3]);
                    *(u32x2*)(H + row * 2816 + f0 + bj * 64) = w; } }
    }
};
struct EpiDown {
    static constexpr bool PERM = false, AFTER_DRAIN = false;
    const float* X1; float* OUT;
    __device__ __forceinline__ void operator()(const f32x4 (&acc)[2][2][4][2], const Unit& u, int wr, int wc, int fr, int fq) const {
        const int row0 = u.pm * BM + wr * 64 + fr, col0 = u.pn * BM + wc * 32 + 4 * fq;
#pragma unroll
        for (int ai = 0; ai < 2; ++ai)
#pragma unroll
            for (int m = 0; m < 4; ++m) { const size_t row = (size_t)(row0 + ai * HALF + m * 16);
#pragma unroll
                for (int bj = 0; bj < 2; ++bj)
#pragma unroll
                    for (int n = 0; n < 2; ++n) { const size_t off = row * 1024 + col0 + bj * HALF + n * 16;
                        *(f32x4*)(OUT + off) = *(const f32x4*)(X1 + off) + acc[ai][bj][m][n]; } }
    }
};
template <class Epi, class Sched, bool ALIGN_EPI = false, bool SP2 = false>
__device__ __forceinline__ void gemm_phase(PG8_LAS unsigned char* lds, const Gemm g, const Sched& S, const Epi& E) {
    const int tid = threadIdx.x, wid = __builtin_amdgcn_readfirstlane(tid >> 6), lane = tid & 63, wr = wid >> 2, wc = wid & 3, fr = lane & 15, fq = lane >> 4;
    const int K = g.K, nt = K / BK;
    unsigned voffA[2], voffB[2];
#pragma unroll
    for (int i = 0; i < 2; ++i) { int R, C; stage_rc(tid * 16 + i * 8192, R, C); const int Rb = Epi::PERM ? ((R & ~31) + perm32(R & 31)) : R;
        voffA[i] = (unsigned)(R * K + C) * 2u; voffB[i] = (unsigned)(Rb * K + C) * 2u; }
    const size_t kstep = (size_t)(BK * 2);
    const size_t hstep = (size_t)HALF * K * 2;
    const size_t tstep = 2 * hstep;
    const unsigned ldsw = (unsigned)wid * 1024u;
    const int aoff = lds_byte(wr * 64 + fr, fq * 8), boff = lds_byte(wc * 32 + fr, fq * 8);
#define PG8_SA(b, h) (((b) * 2 + (h)) * HTB)
#define PG8_SB(b, h) ((4 + (b) * 2 + (h)) * HTB)
#define PG8_STAGE(bufoff, gbase, voff) do { _Pragma("unroll") for (int _i = 0; _i < 2; ++_i) \
        __builtin_amdgcn_global_load_lds((const unsigned*)((const char*)(gbase) + (voff)[_i]), (PG8_LAS unsigned*)(lds + (bufoff) + ldsw + _i * 8192), 16, 0, 0); } while (0)
#define PG8_LDA(dst, b, h) do { _Pragma("unroll") for (int m = 0; m < 4; ++m) _Pragma("unroll") for (int k = 0; k < 2; ++k) dst[m][k] = *(const PG8_LAS bf16x8*)(lds + PG8_SA(b, h) + aoff + m * 2048 + k * 1024); } while (0)
#define PG8_LDB(dst, b, h) do { _Pragma("unroll") for (int n = 0; n < 2; ++n) _Pragma("unroll") for (int k = 0; k < 2; ++k) dst[n][k] = *(const PG8_LAS bf16x8*)(lds + PG8_SB(b, h) + boff + n * 2048 + k * 1024); } while (0)
#define PG8_MMA(ai, bj, At, Bt) do { __builtin_amdgcn_s_setprio(1); _Pragma("unroll") for (int m = 0; m < 4; ++m) _Pragma("unroll") for (int n = 0; n < 2; ++n) _Pragma("unroll") for (int k = 0; k < 2; ++k) \
        acc[ai][bj][m][n] = __builtin_amdgcn_mfma_f32_16x16x32_bf16(Bt[n][k], At[m][k], acc[ai][bj][m][n], 0, 0, 0); __builtin_amdgcn_s_setprio(0); } while (0)
#define PG8_WAIT_V(n) asm volatile("s_waitcnt vmcnt(" #n ")" ::: "memory")
#define PG8_WAIT_L(n) asm volatile("s_waitcnt lgkmcnt(" #n ")" ::: "memory")
#define PG8_BAR __builtin_amdgcn_s_barrier()
#define PG8_SCHED __builtin_amdgcn_sched_barrier(0)
    Unit cur, nxt; int ui = 0;
    if (!S.next(0, cur)) return;
    f32x4 acc[2][2][4][2];
#pragma unroll
    for (int a = 0; a < 2; ++a)
#pragma unroll
        for (int b = 0; b < 2; ++b)
#pragma unroll
            for (int m = 0; m < 4; ++m)
#pragma unroll
                for (int n = 0; n < 2; ++n) acc[a][b][m][n] = (f32x4){0.f, 0.f, 0.f, 0.f};
    bf16x8 At[4][2], B0[2][2], B1[2][2];
    const char* cA = (const char*)g.A + (size_t)cur.pm * tstep; const char* cB = (const char*)g.Bt + (size_t)cur.pn * tstep;
    S.a_ready(cur);
    if constexpr (SP2) {
        PG8_STAGE(PG8_SB(0, 0), cB, voffB); PG8_STAGE(PG8_SB(0, 1), cB + hstep, voffB); PG8_STAGE(PG8_SA(0, 0), cA, voffA); PG8_STAGE(PG8_SA(0, 1), cA + hstep, voffA);
        if (wr == 1) PG8_BAR;
        PG8_WAIT_V(2); PG8_BAR;
        PG8_STAGE(PG8_SB(1, 0), cB + kstep, voffB); PG8_STAGE(PG8_SA(1, 0), cA + kstep, voffA); PG8_STAGE(PG8_SB(1, 1), cB + hstep + kstep, voffB);
        PG8_WAIT_V(6); PG8_BAR;
    } else {
        PG8_STAGE(PG8_SB(0, 0), cB, voffB); PG8_STAGE(PG8_SA(0, 0), cA, voffA); PG8_STAGE(PG8_SB(0, 1), cB + hstep, voffB); PG8_STAGE(PG8_SA(0, 1), cA + hstep, voffA);
        if (wr == 1) PG8_BAR;
        PG8_WAIT_V(4); PG8_BAR;
        PG8_STAGE(PG8_SB(1, 0), cB + kstep, voffB); PG8_STAGE(PG8_SA(1, 0), cA + kstep, voffA); PG8_STAGE(PG8_SB(1, 1), cB + hstep + kstep, voffB);
        PG8_WAIT_V(6); PG8_BAR;
    }
    for (;;) {
        const bool has_next = S.next(ui + 1, nxt);
        const char* nA = has_next ? (const char*)g.A + (size_t)nxt.pm * tstep : cA; const char* nB = has_next ? (const char*)g.Bt + (size_t)nxt.pn * tstep : cB;
        for (int t = 0; t < nt; t += 2) {
            const bool last = (t == nt - 2);
            const char* a1 = cA + (size_t)(t + 1) * kstep;
            const char* a2 = last ? nA : cA + (size_t)(t + 2) * kstep; const char* b2 = last ? nB : cB + (size_t)(t + 2) * kstep;
            const char* a3 = a2 + kstep; const char* b3 = b2 + kstep;
            if (last && has_next) S.a_ready(nxt);
            if constexpr (SP2) {
            PG8_LDB(B0, 0, 0); PG8_LDB(B1, 0, 1); PG8_SCHED; PG8_LDA(At, 0, 0); PG8_STAGE(PG8_SA(1, 1), a1 + hstep, voffA);
            PG8_WAIT_V(8); PG8_WAIT_L(0); PG8_BAR; PG8_MMA(0, 0, At, B0); PG8_MMA(0, 1, At, B1); PG8_BAR; PG8_SCHED;
            PG8_LDA(At, 0, 1); PG8_STAGE(PG8_SB(0, 0), b2, voffB); PG8_STAGE(PG8_SB(0, 1), b2 + hstep, voffB); PG8_STAGE(PG8_SA(0, 0), a2, voffA);
            PG8_WAIT_V(8); PG8_WAIT_L(0); PG8_BAR; PG8_MMA(1, 0, At, B0); PG8_MMA(1, 1, At, B1); PG8_BAR; PG8_SCHED;
            PG8_LDB(B0, 1, 0); PG8_LDB(B1, 1, 1); PG8_SCHED; PG8_LDA(At, 1, 0); PG8_STAGE(PG8_SA(0, 1), a2 + hstep, voffA);
            PG8_WAIT_V(8); PG8_WAIT_L(0); PG8_BAR; PG8_MMA(0, 0, At, B0); PG8_MMA(0, 1, At, B1); PG8_BAR; PG8_SCHED;
            PG8_LDA(At, 1, 1); PG8_STAGE(PG8_SB(1, 0), b3, voffB); PG8_STAGE(PG8_SB(1, 1), b3 + hstep, voffB); PG8_STAGE(PG8_SA(1, 0), a3, voffA);
            PG8_WAIT_V(8); PG8_WAIT_L(0); PG8_BAR; PG8_MMA(1, 0, At, B0); PG8_MMA(1, 1, At, B1); PG8_BAR; PG8_SCHED;
            } else {
            PG8_LDB(B0, 0, 0); PG8_SCHED; PG8_LDA(At, 0, 0); PG8_STAGE(PG8_SA(1, 1), a1 + hstep, voffA);
            PG8_WAIT_L(8); PG8_BAR; PG8_WAIT_L(0); PG8_MMA(0, 0, At, B0); PG8_BAR; PG8_SCHED;
            PG8_LDB(B1, 0, 1); PG8_STAGE(PG8_SB(0, 0), b2, voffB);
            PG8_BAR; PG8_WAIT_L(0); PG8_MMA(0, 1, At, B1); PG8_BAR;
            PG8_LDA(At, 0, 1); PG8_STAGE(PG8_SA(0, 0), a2, voffA);
            PG8_BAR; PG8_WAIT_L(0); PG8_MMA(1, 0, At, B0); PG8_BAR; PG8_SCHED;
            PG8_STAGE(PG8_SB(0, 1), b2 + hstep, voffB);
            PG8_WAIT_V(6); PG8_BAR; PG8_MMA(1, 1, At, B1); PG8_BAR;
            PG8_LDB(B0, 1, 0); PG8_SCHED; PG8_LDA(At, 1, 0); PG8_STAGE(PG8_SA(0, 1), a2 + hstep, voffA);
            PG8_WAIT_L(8); PG8_BAR; PG8_WAIT_L(0); PG8_MMA(0, 0, At, B0); PG8_BAR; PG8_SCHED;
            PG8_LDB(B1, 1, 1); PG8_STAGE(PG8_SB(1, 0), b3, voffB);
            PG8_BAR; PG8_WAIT_L(0); PG8_MMA(0, 1, At, B1); PG8_BAR;
            PG8_LDA(At, 1, 1); PG8_STAGE(PG8_SA(1, 0), a3, voffA);
            PG8_BAR; PG8_WAIT_L(0); PG8_MMA(1, 0, At, B0); PG8_BAR; PG8_SCHED;
            PG8_STAGE(PG8_SB(1, 1), b3 + hstep, voffB);
            PG8_WAIT_V(6); PG8_BAR; PG8_MMA(1, 1, At, B1); PG8_BAR;
            }
        }
        if constexpr (ALIGN_EPI) { if (wr == 0) PG8_BAR; }
        if constexpr (!Epi::AFTER_DRAIN) { E(acc, cur, wr, wc, fr, fq); S.done(cur); }
        if (!has_next) break;
#pragma unroll
        for (int a = 0; a < 2; ++a)
#pragma unroll
            for (int b = 0; b < 2; ++b)
#pragma unroll
                for (int m = 0; m < 4; ++m)
#pragma unroll
                    for (int n = 0; n < 2; ++n) acc[a][b][m][n] = (f32x4){0.f, 0.f, 0.f, 0.f};
        cur = nxt; cA = nA; cB = nB; ++ui;
        if constexpr (ALIGN_EPI) { if (wr == 1) PG8_BAR; }
    }
    PG8_WAIT_V(0);
    if constexpr (!ALIGN_EPI) { if (wr == 0) PG8_BAR; }
    PG8_BAR;
    if constexpr (Epi::AFTER_DRAIN) { E.fused(acc, cur, wr, wc, fr, fq, lds, wid, lane); S.done(cur); }
#undef PG8_SA
#undef PG8_SB
#undef PG8_STAGE
#undef PG8_LDA
#undef PG8_LDB
#undef PG8_MMA
#undef PG8_WAIT_V
#undef PG8_WAIT_L
#undef PG8_BAR
#undef PG8_SCHED
}
}
namespace att {
typedef short s16x4 __attribute__((ext_vector_type(4)));
constexpr int NW = 8, QBLK = 32, KVBLK = 64, QB = 128, D = 128, PITCH = 512, OPITCH = 1024;
constexpr int SHM_V = KVBLK * D * 2, SHM_K = KVBLK * D * 2;
constexpr int LDS_WS = 2 * SHM_V + 2 * SHM_K, LDS_XCH = LDS_WS + NW * 64 * 4, LDS_BYTES = LDS_XCH + 4 * 32 * 128 * 4;
constexpr float SCALE = 0.125f, THR = 8.f;
constexpr unsigned WBIG = 0x40000000u;
#define KSWZ(row, colB) ((row) * 256 + ((colB) ^ (((row) & 7) << 4)))
#define SBAR() __builtin_amdgcn_sched_barrier(0)
__device__ __forceinline__ int v_st(int k, int c) { const int kk = (k & ~0xC) | ((k & 4) << 1) | ((k & 8) >> 1); return ((kk >> 3) * 4 + (c >> 5)) * 512 + ((kk & 7) * 32 + (c & 31)) * 2; }
__device__ __forceinline__ int v_rd_base(int lane) { return ((lane & 3) << 3) | (((lane >> 2) & 3) << 6) | (((lane >> 4) & 1) << 5) | (((lane >> 5) & 1) << 8); }
constexpr int v_rd_off(int d0, int ks, int half) { return d0 * 512 + ks * 4096 + half * 2048; }
__device__ __forceinline__ int crow(int r, int hi) { return (r & 3) + 8 * (r >> 2) + 4 * hi; }
__device__ __forceinline__ unsigned cvtpk(float lo, float hi) { unsigned r; asm volatile("v_cvt_pk_bf16_f32 %0, %1, %2" : "=v"(r) : "v"(lo), "v"(hi)); return r; }
__device__ __forceinline__ bf16x8 load8(const bf16* p) { return *reinterpret_cast<const bf16x8*>(p); }
__device__ __forceinline__ void mask_tile(f32x16& p0, f32x16& p1, int dq, unsigned W) {
    const float NEG = -__builtin_inff();
#pragma unroll
    for (int r = 0; r < 16; ++r) {
        const int c = (r & 3) + 8 * (r >> 2);
        if ((unsigned)(dq - c) >= W) p0[r] = NEG;
        if ((unsigned)(dq - c - 32) >= W) p1[r] = NEG;
    }
}
__device__ __forceinline__ void partialSM(f32x16& p0, f32x16& p1, float& m_reg, float& mn, float& alpha) {
    float pmax = p0[0];
#pragma unroll
    for (int r = 1; r < 16; ++r) pmax = fmaxf(pmax, p0[r]);
#pragma unroll
    for (int r = 0; r < 16; ++r) pmax = fmaxf(pmax, p1[r]);
    { auto rr = __builtin_amdgcn_permlane32_swap(__float_as_uint(pmax), __float_as_uint(pmax), false, false);
      pmax = fmaxf(__uint_as_float(rr[0]), __uint_as_float(rr[1])); }
    constexpr float C2 = 1.4426950408889634f * SCALE;
    if (__builtin_expect(__all((pmax - m_reg) * SCALE <= THR), 1)) { mn = m_reg; alpha = 1.f; }
    else { mn = fmaxf(m_reg, pmax); alpha = __builtin_amdgcn_exp2f((m_reg - mn) * C2); m_reg = mn; }
    const float mnL = -mn * C2;
#pragma unroll
    for (int r = 0; r < 16; ++r) p0[r] = fmaf(p0[r], C2, mnL);
#pragma unroll
    for (int r = 0; r < 16; ++r) p1[r] = fmaf(p1[r], C2, mnL);
#pragma unroll
    for (int r = 0; r < 16; ++r) p0[r] = __builtin_amdgcn_exp2f(p0[r]);
}
__device__ __forceinline__ void finishSM(f32x16& p0, f32x16& p1, float alpha, float& l_reg, bf16x8& pa0, bf16x8& pa1, bf16x8& pa2, bf16x8& pa3) {
#pragma unroll
    for (int r = 0; r < 16; ++r) p1[r] = __builtin_amdgcn_exp2f(p1[r]);
    float ps = 0;
#pragma unroll
    for (int r = 0; r < 16; ++r) ps += p0[r];
#pragma unroll
    for (int r = 0; r < 16; ++r) ps += p1[r];
    { auto rr = __builtin_amdgcn_permlane32_swap(__float_as_uint(ps), __float_as_uint(ps), false, false);
      ps = __uint_as_float(rr[0]) + __uint_as_float(rr[1]); }
    l_reg = l_reg * alpha + ps;
#define PK4(P, B_, OUT) do { unsigned a0 = cvtpk(P[B_+0], P[B_+1]), a1 = cvtpk(P[B_+2], P[B_+3]);                          \
        unsigned b0 = cvtpk(P[B_+4], P[B_+5]), b1 = cvtpk(P[B_+6], P[B_+7]);                                             \
        auto r0 = __builtin_amdgcn_permlane32_swap(a0, b0, false, false); auto r1 = __builtin_amdgcn_permlane32_swap(a1, b1, false, false); \
        v4u w = {r0[0], r1[0], r0[1], r1[1]}; OUT = *reinterpret_cast<bf16x8*>(&w); } while (0)
    PK4(p0, 0, pa0); PK4(p0, 8, pa1); PK4(p1, 0, pa2); PK4(p1, 8, pa3);
#undef PK4
}
template <int KB>
__device__ __forceinline__ void qkt(f32x16& p0, f32x16& p1, const char* K_lds, int r32, int hi, const bf16x8* qr, int kcolB) {
    p0 = f32x16{}; p1 = f32x16{};
#pragma unroll
    for (int d0 = 0; d0 < 4; ++d0) { const char* a = K_lds + KB * SHM_K + KSWZ(r32, (d0 * 16 + hi * 8) * 2 + kcolB);
        bf16x8 b0 = *reinterpret_cast<const bf16x8*>(a);
        bf16x8 b1 = *reinterpret_cast<const bf16x8*>(a + 32 * 256);
        p0 = __builtin_amdgcn_mfma_f32_32x32x16_bf16(b0, qr[d0], p0, 0, 0, 0);
        p1 = __builtin_amdgcn_mfma_f32_32x32x16_bf16(b1, qr[d0], p1, 0, 0, 0); }
}
template <int VB>
__device__ __forceinline__ void pv_tile(f32x16* o, int vb0, bf16x8 pa0, bf16x8 pa1, bf16x8 pa2, bf16x8 pa3) {
#define TRRD(dst, off) asm volatile("ds_read_b64_tr_b16 %0, %1 offset:%2" : "=&v"(dst) : "v"(vb0), "i"(off) : "memory")
#define PV_D0(d0) do { s16x4 l0, l1, l2, l3, h0, h1, h2, h3; constexpr int b_ = VB * SHM_V + v_rd_off(d0, 0, 0);     \
        TRRD(l0, b_); TRRD(h0, b_ + 2048); TRRD(l1, b_ + 4096); TRRD(h1, b_ + 6144); TRRD(l2, b_ + 8192); TRRD(h2, b_ + 10240); TRRD(l3, b_ + 12288); TRRD(h3, b_ + 14336); \
        asm volatile("s_waitcnt lgkmcnt(0)" ::: "memory"); SBAR();                 \
        o[d0] = __builtin_amdgcn_mfma_f32_32x32x16_bf16(pa0, (bf16x8){l0[0], l0[1], l0[2], l0[3], h0[0], h0[1], h0[2], h0[3]}, o[d0], 0, 0, 0);   \
        o[d0] = __builtin_amdgcn_mfma_f32_32x32x16_bf16(pa1, (bf16x8){l1[0], l1[1], l1[2], l1[3], h1[0], h1[1], h1[2], h1[3]}, o[d0], 0, 0, 0);   \
        o[d0] = __builtin_amdgcn_mfma_f32_32x32x16_bf16(pa2, (bf16x8){l2[0], l2[1], l2[2], l2[3], h2[0], h2[1], h2[2], h2[3]}, o[d0], 0, 0, 0);   \
        o[d0] = __builtin_amdgcn_mfma_f32_32x32x16_bf16(pa3, (bf16x8){l3[0], l3[1], l3[2], l3[3], h3[0], h3[1], h3[2], h3[3]}, o[d0], 0, 0, 0); } while (0)
    PV_D0(0); PV_D0(1); PV_D0(2); PV_D0(3);
#undef PV_D0
#undef TRRD
}
struct BlockRef { const bf16* Q; const bf16* K; const bf16* V; bf16* O; int P0; };
struct Seam { bf16x8 qr[4]; bf16x8 st_v0, st_v1, st_k0, st_k1; };
struct Consts { float lam, oscale; const float* subln; };
#define AROW(p, k0, rr) ((p) + (size_t)((k0) + (rr)) * PITCH + sc)
#define VMW() asm volatile("s_waitcnt vmcnt(0)" ::: "memory")
#define VMWN(n) asm volatile("s_waitcnt vmcnt(%0)" :: "i"(n) : "memory")
#define SLOAD_H(Kp, Vp, k0) do { S.st_v0 = load8(AROW(Vp, k0, sr)); S.st_v1 = load8(AROW(Vp, k0, 32 + sr));              \
                         S.st_k0 = load8(AROW(Kp, k0, sr)); S.st_k1 = load8(AROW(Kp, k0, 32 + sr)); } while (0)
#define SWRITE_HK(bf) do { *(bf16x8*)(K_lds + (bf) * SHM_K + kws) = S.st_k0; *(bf16x8*)(K_lds + (bf) * SHM_K + kws + 32 * 256) = S.st_k1; } while (0)
#define SWRITE_HV(bf) do { *(bf16x8*)(V_lds + (bf) * SHM_V + vst0) = S.st_v0; *(bf16x8*)(V_lds + (bf) * SHM_V + vst1) = S.st_v1; } while (0)
#define SWRITE_H(bf) do { SWRITE_HV(bf); SWRITE_HK(bf); } while (0)
__device__ __forceinline__ void prime(const BlockRef& cur, char* lds, Seam& S) {
    const int tid = threadIdx.x, wid = __builtin_amdgcn_readfirstlane(tid >> 6), lane = tid & 63, r32 = lane & 31, hi = lane >> 5;
    const int mw = wid >> 2, wq = wid & 3;
    const int sr = tid >> 4, sc = (tid & 15) * 8, kws = KSWZ(sr, sc * 2); char* K_lds = lds + 2 * SHM_V;
#pragma unroll
    for (int d0 = 0; d0 < 4; ++d0) S.qr[d0] = load8(cur.Q + (size_t)(wq * QBLK + r32) * PITCH + mw * 64 + d0 * 16 + hi * 8);
    SLOAD_H(cur.K, cur.V, 0); VMW(); SWRITE_HK(0);
    __syncthreads();
}
__device__ __forceinline__ void block(const BlockRef& cur, const BlockRef& nxt, char* lds, Seam& S, const Consts& C) {
    const int tid = threadIdx.x, wid = __builtin_amdgcn_readfirstlane(tid >> 6), lane = tid & 63, r32 = lane & 31, hi = lane >> 5;
    const int mw = wid >> 2, wq = wid & 3;
    const int NT = cur.P0 / KVBLK + 2;
    const int qlo = cur.P0 + wq * QBLK, qm = qlo + r32 - 4 * hi;
    char* V_lds = lds; char* K_lds = lds + 2 * SHM_V;
    float* ws = (float*)(lds + LDS_WS) + wid * 64; float* li_l = ws, * al_l = ws + 32;
    float m_reg = -1e30f, l_reg = 0; f32x16 o[4] = {};
    const int sr = tid >> 4, sc = (tid & 15) * 8, vst0 = v_st(sr, sc), vst1 = v_st(32 + sr, sc), kws = KSWZ(sr, sc * 2);
    const int vb0 = (int)(uintptr_t)V_lds + v_rd_base(lane);
    const int kcolB = mw * 128;
    const bf16* Kh = cur.K; const bf16* Vh = cur.V;
#define RESC(a) do { if (__any((a) < 1.f)) { if (hi == 0) al_l[r32] = (a); asm volatile("s_waitcnt lgkmcnt(0)" ::: "memory");              \
                     for (int d_ = 0; d_ < 4; ++d_) for (int r = 0; r < 16; ++r) o[d_][r] *= al_l[crow(r, hi)]; } } while (0)
#define KBASE(t) ((t) * KVBLK)
#define MASKT(P0_, P1_, t) do { const int kb_ = KBASE(t); if (kb_ + KVBLK - 1 > qlo) mask_tile(P0_, P1_, qm - kb_, WBIG); } while (0)
    constexpr int NQL = 4;
#define SEAM_K0() do { VMWN(NQL); SWRITE_HK(0); SBAR(); } while (0)
    f32x16 pA0, pA1, pB0, pB1; float mnA, mnB, alA, alB; bf16x8 pa0, pa1, pa2, pa3;
    SWRITE_HV(0); SBAR();
    if (NT > 1) { SLOAD_H(Kh, Vh, KBASE(1)); }
    SBAR(); qkt<0>(pA0, pA1, K_lds, r32, hi, S.qr, kcolB);
    MASKT(pA0, pA1, 0); partialSM(pA0, pA1, m_reg, mnA, alA);
    if (NT > 1) { VMW(); SWRITE_H(1); }
    __syncthreads();
#define HALF_STEP(PX0, PX1, mnX, alX, PY0, PY1, alY, t, KB, VB, SB) do {                                                      \
        SBAR(); qkt<KB>(PX0, PX1, K_lds, r32, hi, S.qr, kcolB);                                                               \
        finishSM(PY0, PY1, alY, l_reg, pa0, pa1, pa2, pa3); SBAR();                                                           \
        if ((t) + 1 < NT) { SLOAD_H(Kh, Vh, KBASE((t) + 1)); SBAR(); }                                                        \
        pv_tile<VB>(o, vb0, pa0, pa1, pa2, pa3); MASKT(PX0, PX1, (t)); partialSM(PX0, PX1, m_reg, mnX, alX);                  \
        __syncthreads();                                                                                                      \
        if ((t) + 1 < NT) { VMW(); SWRITE_H(SB); }                                                                            \
        RESC(alX); __syncthreads(); } while (0)
    for (int t = 1; t + 1 < NT; t += 2) {
        HALF_STEP(pB0, pB1, mnB, alB, pA0, pA1, alA, t, 1, 0, 0);
        HALF_STEP(pA0, pA1, mnA, alA, pB0, pB1, alB, t + 1, 0, 1, 1);
    }
    const bool even = (NT & 1) == 0;
    if (even) { SBAR(); qkt<1>(pB0, pB1, K_lds, r32, hi, S.qr, kcolB); SBAR(); }
    SLOAD_H(nxt.K, nxt.V, 0); SBAR();
#pragma unroll
    for (int d0 = 0; d0 < 4; ++d0) S.qr[d0] = load8(nxt.Q + (size_t)(wq * QBLK + r32) * PITCH + mw * 64 + d0 * 16 + hi * 8);
    SBAR();
    finishSM(pA0, pA1, alA, l_reg, pa0, pa1, pa2, pa3); SBAR();
    pv_tile<0>(o, vb0, pa0, pa1, pa2, pa3);
    if (even) { MASKT(pB0, pB1, NT - 1); partialSM(pB0, pB1, m_reg, mnB, alB); __syncthreads(); RESC(alB);
        finishSM(pB0, pB1, alB, l_reg, pa0, pa1, pa2, pa3); SBAR(); pv_tile<1>(o, vb0, pa0, pa1, pa2, pa3); }
    SBAR(); SEAM_K0();
    int r32e = r32, hie = hi; asm volatile("" : "+v"(r32e), "+v"(hie));
    if (hie == 0) li_l[r32e] = l_reg; asm volatile("s_waitcnt lgkmcnt(0)" ::: "memory");
    float rli[16];
#pragma unroll
    for (int r = 0; r < 16; ++r) rli[r] = __builtin_amdgcn_rcpf(li_l[crow(r, hie)]);
    float* xch = (float*)(lds + LDS_XCH) + wq * (32 * 128);
    if (mw == 1) {
#pragma unroll
        for (int r = 0; r < 16; ++r) { const int orow = crow(r, hie);
#pragma unroll
            for (int d0 = 0; d0 < 4; ++d0) xch[orow * 128 + d0 * 32 + r32e] = o[d0][r] * rli[r]; }
    }
    __syncthreads();
    if (mw == 0) {
        bf16* Ow = cur.O + (size_t)(wq * QBLK) * OPITCH;
        float sub[4];
#pragma unroll
        for (int d0 = 0; d0 < 4; ++d0) sub[d0] = C.subln[d0 * 32 + r32e];
#pragma unroll
        for (int r = 0; r < 16; ++r) { const int orow = crow(r, hie); float a[4]; float ss = 0.f;
#pragma unroll
            for (int d0 = 0; d0 < 4; ++d0) { a[d0] = o[d0][r] * rli[r] - C.lam * xch[orow * 128 + d0 * 32 + r32e]; ss += a[d0] * a[d0]; }
#pragma unroll
            for (int ofs = 1; ofs < 32; ofs <<= 1) ss += __shfl_xor(ss, ofs);
            const float rs = __builtin_amdgcn_rsqf(ss * (1.0f / 128.0f) + EPS) * C.oscale;
#pragma unroll
            for (int d0 = 0; d0 < 4; ++d0) { const float v = a[d0] * rs * sub[d0]; const float vn = __shfl_xor(v, 1);
                if ((r32e & 1) == 0) *(unsigned*)(Ow + (size_t)orow * OPITCH + d0 * 32 + r32e) = cvtpk(v, vn); } }
    }
    __syncthreads();
#undef RESC
#undef KBASE
#undef MASKT
#undef SEAM_K0
#undef HALF_STEP
}
__device__ __forceinline__ BlockRef mkref(int L, int pass, const bf16* QA, const bf16* KA, const bf16* VA, bf16* MRG) {
    const int bh = L & 7, b = bh >> 2, h = bh & 3, y = L >> 3, qb = pass ? 63 - y : y;
    BlockRef r; r.P0 = qb * QB;
    r.Q = QA + ((size_t)b * SEQ + r.P0) * PITCH + h * 128; r.K = KA + (size_t)b * SEQ * PITCH + h * 128; r.V = VA + (size_t)b * SEQ * PITCH + h * 128;
    r.O = MRG + ((size_t)b * SEQ + r.P0) * OPITCH + 512 + h * 128;
    return r;
}
__device__ __forceinline__ void attn_phase(char* lds, const bf16* QA, const bf16* KA, const bf16* VA, bf16* MRG, const Consts& C, int G, int bx) {
    constexpr int total = 256;
    int L = bx; if (L >= total) return;
    int pass = 0;
    BlockRef cur = mkref(L, 0, QA, KA, VA, MRG);
    Seam S;
    prime(cur, lds, S);
    for (;;) {
        const bool more_pass = pass == 0, more_item = L + G < total, last = !more_pass && !more_item;
        int passn = pass + 1, Ln = L;
        if (!more_pass) { passn = 0; Ln = more_item ? L + G : L; }
        const BlockRef nxt = last ? cur : mkref(Ln, passn, QA, KA, VA, MRG);
        block(cur, nxt, lds, S, C);
        if (last) break;
        cur = nxt; pass = passn; L = Ln;
    }
}
#undef AROW
#undef VMW
#undef VMWN
#undef SLOAD_H
#undef SWRITE_HK
#undef SWRITE_HV
#undef SWRITE_H
#undef KSWZ
#undef SBAR
}
#define XB_TMO      128
#define XB_XCNT(j)  (256  + 64 * (j))
#define XB_XSUB(j)  (1280 + 64 * (j))
#define XB_XGEN(j)  (2304 + 64 * (j))
#define XB_TOP      3328
#define XB_TOPGEN   3392
#define XCD_BAR_WORDS 3456
#define XB_SPIN_CAP (1u << 18)

__device__ __forceinline__ unsigned xb_ld(unsigned* p)              { return __hip_atomic_load(p, __ATOMIC_RELAXED, __HIP_MEMORY_SCOPE_AGENT); }
__device__ __forceinline__ unsigned xb_add(unsigned* p, unsigned v) { return __hip_atomic_fetch_add(p, v, __ATOMIC_RELAXED, __HIP_MEMORY_SCOPE_AGENT); }
__device__ __forceinline__ unsigned xb_xcc_id() { return (unsigned)__builtin_amdgcn_s_getreg((3 << 11) | 20) & 0xFu; }
#define XB_SPIN(cond, bar) do { unsigned _sp = 0; while (cond) { __builtin_amdgcn_s_sleep(1); \
    if ((++_sp & 255u) == 0u) { if (xb_ld(&(bar)[XB_TMO])) break; if (_sp > XB_SPIN_CAP) { atomicAdd(&(bar)[XB_TMO], 1u); break; } } } } while (0)

struct XcdBarrier {
    unsigned* bar; unsigned x;
    volatile LAS unsigned* st;
};

__device__ __forceinline__ XcdBarrier xcd_barrier_post(unsigned* bar, volatile LAS unsigned* st) {
    XcdBarrier b; b.bar = bar; b.x = xb_xcc_id(); b.st = st;
    if (threadIdx.x == 0) (void)xb_add(&bar[XB_XCNT(b.x)], 1u);
    return b;
}
__device__ __forceinline__ void xcd_barrier_complete(unsigned* bar, unsigned x, unsigned& nloc, unsigned& nx) {
    const unsigned G = gridDim.x * gridDim.y * gridDim.z;
    unsigned sum, cnt, mine, sp = 0u;
    for (;;) {
        sum = 0u; cnt = 0u; mine = 0u;
#pragma unroll
        for (unsigned j = 0; j < 16; ++j) { const unsigned c = xb_ld(&bar[XB_XCNT(j)]); sum += c; cnt += (c > 0u) ? 1u : 0u; mine = (j == x) ? c : mine; }
        if (sum == G) break;
        __builtin_amdgcn_s_sleep(1);
        if ((++sp & 255u) == 0u) { if (xb_ld(&bar[XB_TMO])) break; if (sp > XB_SPIN_CAP) { atomicAdd(&bar[XB_TMO], 1u); break; } }
    }
    nloc = mine > 0u ? mine : 1u; nx = cnt > 0u ? cnt : 1u;
}

__device__ __forceinline__ void xcd_barrier(const XcdBarrier& b) {
    asm volatile("s_waitcnt vmcnt(0)" ::: "memory");
    __syncthreads();
    if (threadIdx.x == 0) {
        unsigned* bar = b.bar;
        __builtin_amdgcn_s_waitcnt(0);
        unsigned nloc = b.st[0], nx = b.st[1];
        if (nloc == 0u) { xcd_barrier_complete(bar, b.x, nloc, nx); b.st[0] = nloc; b.st[1] = nx; }
        const unsigned old = xb_add(&bar[XB_XSUB(b.x)], 1u);
        const unsigned gen = old / nloc;
        if (old + 1u == (gen + 1u) * nloc) {
            __builtin_amdgcn_fence(__ATOMIC_RELEASE, "agent");
            asm volatile("s_waitcnt vmcnt(0)" ::: "memory");
            const unsigned og = xb_add(&bar[XB_TOP], 1u);
            const unsigned tg = og / nx;
            if (og + 1u == (tg + 1u) * nx) xb_add(&bar[XB_TOPGEN], 1u);
            else XB_SPIN(xb_ld(&bar[XB_TOPGEN]) == tg, bar);
            __builtin_amdgcn_fence(__ATOMIC_ACQUIRE, "agent");
            xb_add(&bar[XB_XGEN(b.x)], 1u);
            asm volatile("s_waitcnt vmcnt(0)" ::: "memory");
        } else {
            XB_SPIN(xb_ld(&bar[XB_XGEN(b.x)]) == gen, bar);
            __builtin_amdgcn_fence(__ATOMIC_ACQUIRE, "agent");
            asm volatile("s_waitcnt vmcnt(0)" ::: "memory");
        }
    }
    __syncthreads();
}
constexpr int NWAVES = 8;
__device__ __forceinline__ f32x16 mfma32(bf16x8 a, bf16x8 b, f32x16 c) { return __builtin_amdgcn_mfma_f32_32x32x16_bf16(a, b, c, 0, 0, 0); }
__device__ __forceinline__ int crow32(int r, int hi) { return (r & 3) + 8 * (r >> 2) + 4 * hi; }
__device__ __forceinline__ f32x16 mm32(const unsigned char* A, int astr, const unsigned char* B, int bstr, int ksteps, int r, int hh) {
    f32x16 acc = {};
    for (int s = 0; s < ksteps; ++s) {
        const bf16x8 a = *(const bf16x8*)(A + r * astr + (16 * s + 8 * hh) * 2);
        const bf16x8 b = *(const bf16x8*)(B + r * bstr + (16 * s + 8 * hh) * 2);
        acc = mfma32(a, b, acc);
    }
    return acc;
}

template <int MODE>
__device__ __forceinline__ void p0_transpose_item(const float* W, int K, int N, bf16* WT, const float* kscale, float* scr, int item, int lane) {
    const int nblk = N / 32, kb = item / nblk, nb = item % nblk, k0 = 64 * kb, n0 = 32 * nb;
#pragma unroll 8
    for (int i = 0; i < 32; ++i) { const int kk = 2 * i + (lane >> 5); float w = W[(size_t)(k0 + kk) * N + n0 + (lane & 31)]; if (kscale) w *= kscale[k0 + kk]; scr[kk * 33 + (lane & 31)] = w; }
    LDS_WAIT(); asm volatile("" ::: "memory");
    const int c = lane & 7;
#pragma unroll
    for (int j = 0; j < 4; ++j) { const int n = (lane >> 3) + 8 * j; const float* s = scr + (8 * c) * 33 + n;
        v4u o; o.x = pk2(s[0 * 33], s[1 * 33]); o.y = pk2(s[2 * 33], s[3 * 33]); o.z = pk2(s[4 * 33], s[5 * 33]); o.w = pk2(s[6 * 33], s[7 * 33]);
        const int gn = n0 + n; const int drow = MODE == 0 ? gn : ((gn >> 2) * 8 + (gn & 3) + (MODE == 2 ? 4 : 0));
        *(v4u*)(WT + (size_t)drow * K + k0 + 8 * c) = o; }
    LDS_WAIT(); asm volatile("" ::: "memory");
}
__device__ __forceinline__ void rms_row_to_bf16(const float* xrow, const float* gain, bf16* orow, int lane) {
    const f32x4* xr = (const f32x4*)xrow + lane; const f32x4* gr = (const f32x4*)gain + lane;
    f32x4 v[4]; float s = 0.f;
#pragma unroll
    for (int j = 0; j < 4; ++j) { v[j] = xr[64 * j]; s += (v[j].x * v[j].x + v[j].y * v[j].y) + (v[j].z * v[j].z + v[j].w * v[j].w); }
    const float rstd = __builtin_amdgcn_rsqf(wave_sum(s) * (1.f / DM) + EPS);
    unsigned long long* o8 = (unsigned long long*)orow + lane;
#pragma unroll
    for (int j = 0; j < 4; ++j) { const f32x4 g = gr[64 * j]; o8[64 * j] = (unsigned long long)pk2(v[j].x * rstd * g.x, v[j].y * rstd * g.y) | ((unsigned long long)pk2(v[j].z * rstd * g.z, v[j].w * rstd * g.w) << 32); }
}
__device__ __forceinline__ void rms_row_inplace(float* xrow, const float* gain, int lane) {
    f32x4* xr = (f32x4*)xrow + lane; const f32x4* gr = (const f32x4*)gain + lane;
    f32x4 v[4]; float s = 0.f;
#pragma unroll
    for (int j = 0; j < 4; ++j) { v[j] = xr[64 * j]; s += (v[j].x * v[j].x + v[j].y * v[j].y) + (v[j].z * v[j].z + v[j].w * v[j].w); }
    const float rstd = __builtin_amdgcn_rsqf(wave_sum(s) * (1.f / DM) + EPS);
#pragma unroll
    for (int j = 0; j < 4; ++j) { const f32x4 g = gr[64 * j]; xr[64 * j] = v[j] * rstd * g; }
}

template <int KDIM>
__device__ __forceinline__ f32x4 mini_tile(const bf16* A, const bf16* Brow, int wave, int lane) {
    const bf16* ap = A + (size_t)(16 * wave + (lane & 15)) * KDIM + 8 * (lane >> 4);
    const bf16* bp = Brow + 8 * (lane >> 4);
    f32x4 acc = {0.f, 0.f, 0.f, 0.f};
#pragma unroll 8
    for (int k0 = 0; k0 < KDIM; k0 += 32) {
        const bf16x8 a = *(const bf16x8*)(ap + k0), b = *(const bf16x8*)(bp + k0);
        acc = __builtin_amdgcn_mfma_f32_16x16x32_bf16(a, b, acc, 0, 0, 0);
    }
    return acc;
}

namespace hg {
constexpr int QT_OFF = 0, KT_OFF = 64 * 272, KTT_OFF = KT_OFF + 64 * 272, VT_OFF = KTT_OFF + 128 * 144, AM_OFF = VT_OFF + 128 * 144, SEG_OFF = AM_OFF + 64 * 144, SCL_OFF = SEG_OFF + 2048;
__device__ __forceinline__ void h1_unit(unsigned char* lds, int u, const bf16* QS, const float* G, const bf16* VR, bf16* QBg, float* KVT, float* DEC, float* OI, int tid, int wave, int lane) {
    const int bh = u >> 7, c = u & 127, b = bh >> 2, h = bh & 3, row0 = b * SEQ + c * CH, colb = h * 128;
    const int col = tid & 127, seg = tid >> 7;
    unsigned char* QT = lds + QT_OFF; unsigned char* KT = lds + KT_OFF; unsigned char* KTT = lds + KTT_OFF; unsigned char* VT = lds + VT_OFF; unsigned char* AM = lds + AM_OFF;
    float* SEG = (float*)(lds + SEG_OFF); float* SCL = (float*)(lds + SCL_OFF);
    float cs[16]; unsigned short qs[16], vv[16];
    { const size_t base = (size_t)(row0 + seg * 16) * 512 + colb + col;
#pragma unroll
      for (int j = 0; j < 16; ++j) { cs[j] = G[base + (size_t)j * 512]; qs[j] = QS[base + (size_t)j * 512]; vv[j] = VR[base + (size_t)j * 512]; } }
    float gk[16];
#pragma unroll
    for (int j = 0; j < 16; ++j) gk[j] = 1.0f - fexp(cs[j]);
#pragma unroll
    for (int j = 1; j < 16; ++j) cs[j] += cs[j - 1];
    SEG[seg * 128 + col] = cs[15];
    __syncthreads();
    const float t0 = SEG[col], t1 = SEG[128 + col], t2 = SEG[256 + col], t3 = SEG[384 + col];
    const float pre = (seg > 0 ? t0 : 0.f) + (seg > 1 ? t1 : 0.f) + (seg > 2 ? t2 : 0.f);
    const float bref = t0 + t1, blast = (t0 + t1) + (t2 + t3);
    if (seg == 0) { DEC[(size_t)u * 128 + col] = fexp(blast); SCL[col] = fexp(blast - bref); }
    unsigned ktp[8], vtp[8];
#pragma unroll
    for (int j = 0; j < 16; j += 2) {
        float kt2[2];
#pragma unroll
        for (int e = 0; e < 2; ++e) { const int jj = j + e; const float bb = cs[jj] + pre, qv = bf2f(qs[jj]);
            const float qt = qv * fexp(bb - bref), kt = gk[jj] * fexp(bref - bb), qb = qv * fexp(bb);
            const int row = seg * 16 + jj;
            *(unsigned short*)(QT + row * 272 + col * 2) = (unsigned short)f2bf(qt);
            *(unsigned short*)(KT + row * 272 + col * 2) = (unsigned short)f2bf(kt);
            QBg[(size_t)(row0 + row) * 512 + colb + col] = (unsigned short)f2bf(qb);
            kt2[e] = kt; }
        ktp[j >> 1] = pk2(kt2[0], kt2[1]); vtp[j >> 1] = (unsigned)vv[j] | ((unsigned)vv[j + 1] << 16);
    }
    *(v4u*)(KTT + col * 144 + seg * 32) = (v4u){ktp[0], ktp[1], ktp[2], ktp[3]}; *(v4u*)(KTT + col * 144 + seg * 32 + 16) = (v4u){ktp[4], ktp[5], ktp[6], ktp[7]};
    *(v4u*)(VT + col * 144 + seg * 32) = (v4u){vtp[0], vtp[1], vtp[2], vtp[3]}; *(v4u*)(VT + col * 144 + seg * 32 + 16) = (v4u){vtp[4], vtp[5], vtp[6], vtp[7]};
    __syncthreads();
    const int r = lane & 31, hh = lane >> 5;
#pragma unroll
    for (int tt = 0; tt < 2; ++tt) { const int vi = wave >> 1, ki = (wave & 1) * 2 + tt;
        const f32x16 acc = mm32(VT + vi * 32 * 144, 144, KTT + ki * 32 * 144, 144, 4, r, hh);
        const int k = ki * 32 + r; const float sc = SCL[k];
#pragma unroll
        for (int i = 0; i < 16; ++i) { const int v = vi * 32 + crow32(i, hh); KVT[((size_t)u * 128 + v) * 128 + k] = acc[i] * sc; } }
    if (wave < 4) { const int ti = wave >> 1, si = wave & 1;
        const f32x16 acc = mm32(QT + ti * 32 * 272, 272, KT + si * 32 * 272, 272, 8, r, hh);
        const int s = si * 32 + r;
#pragma unroll
        for (int i = 0; i < 16; ++i) { const int t = ti * 32 + crow32(i, hh); *(unsigned short*)(AM + t * 144 + s * 2) = (unsigned short)f2bf(s <= t ? acc[i] : 0.f); } }
    __syncthreads();
    { const int ti = wave >> 2, vi = wave & 3;
        const f32x16 acc = mm32(AM + ti * 32 * 144, 144, VT + vi * 32 * 144, 144, 4, r, hh);
        const int v = vi * 32 + r;
#pragma unroll
        for (int i = 0; i < 16; ++i) { const int t = ti * 32 + crow32(i, hh); OI[(size_t)(row0 + t) * 512 + colb + v] = acc[i]; } }
    __syncthreads();
}
__device__ __forceinline__ void h2_scan(int idx, const float* KVT, const float* DEC, bf16* ST, float* sout) {
    const int bh = idx >> 14, vk = idx & 16383, k = idx & 127, v = (idx >> 7) & 127;
    const float* kv = KVT + (size_t)bh * 128 * 16384 + vk; const float* dc = DEC + (size_t)bh * 128 * 128 + k; bf16* st = ST + (size_t)bh * 128 * 16384 + vk;
    float s = 0.f;
    for (int c0 = 0; c0 < NCH; c0 += 8) {
        float a[8], d[8];
#pragma unroll
        for (int j = 0; j < 8; ++j) { a[j] = kv[(size_t)(c0 + j) * 16384]; d[j] = dc[(c0 + j) * 128]; }
#pragma unroll
        for (int j = 0; j < 8; ++j) { st[(size_t)(c0 + j) * 16384] = (unsigned short)f2bf(s); s = d[j] * s + a[j]; }
    }
    sout[((size_t)bh * 128 + k) * 128 + v] = s;
}
constexpr int QBL_OFF = 0, STL_OFF = 64 * 272, RS_OFF = STL_OFF + 128 * 272;
__device__ __forceinline__ void h3_unit(unsigned char* lds, int u, const bf16* QBg, const bf16* ST, const float* OI, const bf16* GS, const float* rgn, bf16* MRG, int tid, int wave, int lane) {
    const int bh = u >> 7, c = u & 127, b = bh >> 2, h = bh & 3, row0 = b * SEQ + c * CH, colb = h * 128;
    unsigned char* QBL = lds + QBL_OFF; unsigned char* STL = lds + STL_OFF; float* RS = (float*)(lds + RS_OFF);
#pragma unroll
    for (int i = 0; i < 2; ++i) { const int q = tid + 512 * i, row = q >> 4, c16 = q & 15;
        *(v4u*)(QBL + row * 272 + c16 * 16) = *(const v4u*)(QBg + (size_t)(row0 + row) * 512 + colb + c16 * 8); }
#pragma unroll
    for (int i = 0; i < 4; ++i) { const int q = tid + 512 * i, v = q >> 4, c16 = q & 15;
        *(v4u*)(STL + v * 272 + c16 * 16) = *(const v4u*)(ST + ((size_t)u * 128 + v) * 128 + c16 * 8); }
    __syncthreads();
    const int r = lane & 31, hh = lane >> 5, ti = wave >> 2, vi = wave & 3, v = vi * 32 + r;
    const f32x16 acc = mm32(QBL + ti * 32 * 272, 272, STL + vi * 32 * 272, 272, 8, r, hh);
    float o[16];
#pragma unroll
    for (int i = 0; i < 16; ++i) { const int t = ti * 32 + crow32(i, hh); o[i] = acc[i] + OI[(size_t)(row0 + t) * 512 + colb + v];
        float ss = o[i] * o[i];
#pragma unroll
        for (int ofs = 1; ofs < 32; ofs <<= 1) ss += __shfl_xor(ss, ofs);
        if (r == 0) RS[t * 4 + vi] = ss; }
    __syncthreads();
    const float gn = rgn[v];
#pragma unroll
    for (int i = 0; i < 16; ++i) { const int t = ti * 32 + crow32(i, hh);
        const f32x4 p = *(const f32x4*)(RS + t * 4); const float rstd = __builtin_amdgcn_rsqf(((p[0] + p[1]) + (p[2] + p[3])) * (1.0f / 128.0f) + EPS);
        const float gs = bf2f(GS[(size_t)(row0 + t) * 512 + colb + v]);
        MRG[(size_t)(row0 + t) * 1024 + colb + v] = (unsigned short)f2bf(o[i] * rstd * gn * gs); }
    __syncthreads();
}
}

namespace dec {
constexpr int WML_OFF = 0, WO_OFF = 1024, LDS_BYTES = WO_OFF + 8 * 2 * 512 * 4;
#ifndef DEC_NT
#define DEC_NT 0
#endif
__device__ __forceinline__ void partial_wave(int unit, const float* cache_k, const float* cache_v, const int* ptab, const float* PSs, float* PARTML, float* PARTO, int lane) {
    const int i = unit >> 4, page = ptab[unit];
    const float* Kp = cache_k + (size_t)page * 65536 + 8 * lane;
    const float* Vp = cache_v + (size_t)page * 65536 + 8 * lane;
    float q[8];
    { const f32x4 q0 = *(const f32x4*)(PSs + (size_t)i * DIN + 2048 + 8 * lane), q1 = *(const f32x4*)(PSs + (size_t)i * DIN + 2048 + 8 * lane + 4);
#pragma unroll
      for (int e = 0; e < 4; ++e) { q[e] = q0[e] * (0.125f * LOG2E); q[4 + e] = q1[e] * (0.125f * LOG2E); } }
#if DEC_NT
#define NTL(p) __builtin_nontemporal_load((const f32x4*)(p))
#else
#define NTL(p) (*(const f32x4*)(p))
#endif
#define DPPF(x, ctrl) __builtin_bit_cast(float, __builtin_amdgcn_update_dpp(0, __builtin_bit_cast(int, (x)), (ctrl), 0xf, 0xf, true))
    const bool hi8 = (lane & 8) != 0;
    float m0 = -1e30f, m1 = -1e30f, l0 = 0.f, l1 = 0.f, o0[8], o1[8];
#pragma unroll
    for (int e = 0; e < 8; ++e) { o0[e] = 0.f; o1[e] = 0.f; }
    f32x4 kA[4][2], vA[4][2], kB[4][2], vB[4][2];
#define LOADG(KX, VX, g) do { _Pragma("unroll") for (int kk = 0; kk < 4; ++kk) { const size_t ro = (size_t)((g) * 4 + kk) * 512; \
        KX[kk][0] = NTL(Kp + ro); KX[kk][1] = NTL(Kp + ro + 4); VX[kk][0] = NTL(Vp + ro); VX[kk][1] = NTL(Vp + ro + 4); } } while (0)
#define PROCG(KX, VX) do { float s0[4], s1[4]; \
        _Pragma("unroll") for (int kk = 0; kk < 4; ++kk) { \
            float d = (KX[kk][0][0] * q[0] + KX[kk][0][1] * q[1]) + (KX[kk][0][2] * q[2] + KX[kk][0][3] * q[3]) + (KX[kk][1][0] * q[4] + KX[kk][1][1] * q[5]) + (KX[kk][1][2] * q[6] + KX[kk][1][3] * q[7]); \
            d += DPPF(d, 0xB1); d += DPPF(d, 0x4E); d += DPPF(d, 0x141); const float e_ = DPPF(d, 0x128); s0[kk] = hi8 ? e_ : d; s1[kk] = hi8 ? d : e_; } \
        const float n0 = fmaxf(fmaxf(fmaxf(s0[0], s0[1]), fmaxf(s0[2], s0[3])), m0), n1 = fmaxf(fmaxf(fmaxf(s1[0], s1[1]), fmaxf(s1[2], s1[3])), m1); \
        const float a0 = __builtin_amdgcn_exp2f(m0 - n0), a1 = __builtin_amdgcn_exp2f(m1 - n1); m0 = n0; m1 = n1; \
        float ps0 = 0.f, ps1 = 0.f; \
        _Pragma("unroll") for (int kk = 0; kk < 4; ++kk) { s0[kk] = __builtin_amdgcn_exp2f(s0[kk] - n0); s1[kk] = __builtin_amdgcn_exp2f(s1[kk] - n1); ps0 += s0[kk]; ps1 += s1[kk]; } \
        l0 = l0 * a0 + ps0; l1 = l1 * a1 + ps1; \
        _Pragma("unroll") for (int e = 0; e < 4; ++e) { \
            o0[e] = o0[e] * a0 + ((s0[0] * VX[0][0][e] + s0[1] * VX[1][0][e]) + (s0[2] * VX[2][0][e] + s0[3] * VX[3][0][e])); \
            o0[4 + e] = o0[4 + e] * a0 + ((s0[0] * VX[0][1][e] + s0[1] * VX[1][1][e]) + (s0[2] * VX[2][1][e] + s0[3] * VX[3][1][e])); \
            o1[e] = o1[e] * a1 + ((s1[0] * VX[0][0][e] + s1[1] * VX[1][0][e]) + (s1[2] * VX[2][0][e] + s1[3] * VX[3][0][e])); \
            o1[4 + e] = o1[4 + e] * a1 + ((s1[0] * VX[0][1][e] + s1[1] * VX[1][1][e]) + (s1[2] * VX[2][1][e] + s1[3] * VX[3][1][e])); } } while (0)
    LOADG(kA, vA, 0);
    for (int g = 0; g < 32; g += 2) {
        LOADG(kB, vB, g + 1);
        PROCG(kA, vA);
        if (g + 2 < 32) LOADG(kA, vA, g + 2);
        PROCG(kB, vB);
    }
#undef LOADG
#undef PROCG
#undef NTL
#undef DPPF
    if ((lane & 7) == 0) { const int hm = lane >> 3; PARTML[((size_t)unit * 8 + hm) * 2] = hi8 ? m1 : m0; PARTML[((size_t)unit * 8 + hm) * 2 + 1] = hi8 ? l1 : l0; }
    { float* w0 = PARTO + ((size_t)unit * 2 + 0) * 512 + 8 * lane; float* w1 = PARTO + ((size_t)unit * 2 + 1) * 512 + 8 * lane;
      *(f32x4*)w0 = (f32x4){o0[0], o0[1], o0[2], o0[3]}; *(f32x4*)(w0 + 4) = (f32x4){o0[4], o0[5], o0[6], o0[7]};
      *(f32x4*)w1 = (f32x4){o1[0], o1[1], o1[2], o1[3]}; *(f32x4*)(w1 + 4) = (f32x4){o1[4], o1[5], o1[6], o1[7]}; }
}
__device__ __forceinline__ void combine_item(unsigned char* lds, int i, const float* PSs, const float* PARTML, const float* PARTO, const float* subln, float lam, bf16* MRGs, int tid, int wave, int lane) {
    float* CW = (float*)lds;
    float* SSQ = (float*)(lds + 1024);
    { const int hm = wave;
      const float qv = PSs[(size_t)i * DIN + 2048 + hm * 64 + lane] * (0.125f * LOG2E), kn = PSs[(size_t)i * DIN + 2560 + hm * 64 + lane];
      const float sn = wave_sum(qv * kn);
      float Mj = -1e30f, Lj = 0.f;
      if (lane < 16) { Mj = PARTML[(((size_t)i * 16 + lane) * 8 + hm) * 2]; Lj = PARTML[(((size_t)i * 16 + lane) * 8 + hm) * 2 + 1]; }
      const float M = fmaxf(wave_max(Mj), sn);
      const float wj = (lane < 16) ? __builtin_amdgcn_exp2f(Mj - M) : 0.f, wn = __builtin_amdgcn_exp2f(sn - M);
      const float Lt = wave_sum(wj * Lj) + wn, inv = 1.0f / Lt;
      if (lane < 16) CW[hm * 17 + lane] = wj * inv;
      if (lane == 16) CW[hm * 17 + 16] = wn * inv; }
    __syncthreads();
    const int h = tid >> 7;
    float om[2];
#pragma unroll
    for (int m = 0; m < 2; ++m) { const int hm = 2 * h + m; float a = CW[hm * 17 + 16] * PSs[(size_t)i * DIN + 3072 + tid];
#pragma unroll
        for (int j = 0; j < 16; ++j) a += CW[hm * 17 + j] * PARTO[(((size_t)i * 16 + j) * 2 + m) * 512 + tid];
        om[m] = a; }
    const float a = om[0] - lam * om[1];
    const float ssw = wave_sum(a * a);
    if (lane == 0) SSQ[wave] = ssw;
    __syncthreads();
    const float ss = SSQ[2 * h] + SSQ[2 * h + 1];
    const float rstd = __builtin_amdgcn_rsqf(ss * (1.0f / 128.0f) + EPS);
    MRGs[(size_t)i * 1024 + 512 + tid] = (unsigned short)f2bf(a * rstd * subln[tid & 127] * (1.0f - LAM_INIT));
    __syncthreads();
}
__device__ __forceinline__ void recurrent_unit(unsigned char* lds, int unit, const float* PSs, const float* state, const float* lbp, const float* rgn, float* sout, bf16* MRGs, int tid, int wave, int lane) {
    const int i = unit >> 2, h = unit & 3;
    float* RO = (float*)lds;
    float* SSQ = (float*)(lds + 8192);
    const int v4 = (tid & 31) * 4, ks = tid >> 5;
    const float* ps = PSs + (size_t)i * DIN;
    const f32x4 vv = *(const f32x4*)(ps + 1024 + h * 128 + v4);
    const float* sp = state + ((size_t)unit * 128) * 128 + v4; float* so = sout + ((size_t)unit * 128) * 128 + v4;
    f32x4 po = {0.f, 0.f, 0.f, 0.f};
    f32x4 sold[8];
#pragma unroll
    for (int jj = 0; jj < 8; ++jj) sold[jj] = *(const f32x4*)(sp + (size_t)(ks + 16 * jj) * 128);
#pragma unroll
    for (int jj = 0; jj < 8; ++jj) { const int k = ks + 16 * jj, kc = h * 128 + k;
        const float lb = sigm(lbp[kc] - lbp[512 + kc]); const float f = lb + (1.0f - lb) * sigm(ps[512 + kc]); const float kk = 1.0f - f, qk = siluf(ps[kc]);
        const f32x4 sn = sold[jj] * f + vv * kk; *(f32x4*)(so + (size_t)k * 128) = sn; po += sn * qk; }
    *(f32x4*)(RO + ks * 128 + v4) = po;
    __syncthreads();
    float o = 0.f;
    if (tid < 128) {
#pragma unroll
        for (int j = 0; j < 16; ++j) o += RO[j * 128 + tid];
        const float ssw = wave_sum(o * o); if (lane == 0) SSQ[wave] = ssw; }
    __syncthreads();
    if (tid < 128) { const float rstd = __builtin_amdgcn_rsqf((SSQ[0] + SSQ[1]) * (1.0f / 128.0f) + EPS);
        MRGs[(size_t)i * 1024 + h * 128 + tid] = (unsigned short)f2bf(o * rstd * rgn[tid] * siluf(ps[1536 + h * 128 + tid])); }
    __syncthreads();
}
}
#ifndef MK_N_LAUNCHES
#define MK_N_LAUNCHES 1
#endif
constexpr int N_PHASES = 9;
constexpr int N_LAUNCHES = MK_N_LAUNCHES;
static_assert(N_LAUNCHES == 1 || N_LAUNCHES == N_PHASES, "MK_N_LAUNCHES is 1 or 9");
constexpr size_t MiB = 1u << 20;
constexpr size_t WS_CTL = 0, CTL_ZERO_BYTES = 1 * MiB;
constexpr size_t WS_WIN = 2 * MiB;
constexpr size_t WS_WOUT = 10 * MiB;
constexpr size_t WS_WGU = 12 * MiB;
constexpr size_t WS_WD = 24 * MiB;
constexpr size_t WS_PSS = 30 * MiB;
constexpr size_t WS_PS1 = 32 * MiB;
constexpr size_t WS_PS1S = 33 * MiB;
constexpr size_t WS_DEC = 34 * MiB;
constexpr size_t WS_PML = 35 * MiB;
constexpr size_t WS_PO = 36 * MiB;
constexpr size_t WS_XN = 48 * MiB;
constexpr size_t WS_QS = 96 * MiB, WS_VR = 112 * MiB, WS_GS = 128 * MiB, WS_QA = 144 * MiB, WS_KA = 160 * MiB, WS_VA = 176 * MiB;
constexpr size_t WS_G = 192 * MiB;
constexpr size_t WS_QB = 224 * MiB;
constexpr size_t WS_OI = 240 * MiB;
constexpr size_t WS_KVT = 272 * MiB;
constexpr size_t WS_ST = 336 * MiB;
constexpr size_t WS_MRG = 368 * MiB;
constexpr size_t WS_X1 = 416 * MiB;
constexpr size_t WS_XB = 496 * MiB;
constexpr size_t WS_H = 544 * MiB;
constexpr size_t WS_END = 640 * MiB;
constexpr int CW_TMO = 0, CW_BAR = 4096;
constexpr size_t O_Y = 0, O_YS = (size_t)MP * DM, O_KP = O_YS + (size_t)MS * DM, O_VP = O_KP + (size_t)MP * 512, O_SP = O_VP + (size_t)MP * 512,
                 O_KS = O_SP + 8 * 16384, O_VS = O_KS + (size_t)MS * 512, O_SS = O_VS + (size_t)MS * 512, O_END = O_SS + (size_t)MS * 4 * 16384;
constexpr int RING_OFF = 0, RING_BYTES = 143360;
constexpr int LDSCTL_OFF = RING_BYTES, MISC_OFF = LDSCTL_OFF + 320;
constexpr int LDS_BYTES = 147456;
static_assert(att::LDS_BYTES <= RING_BYTES && MISC_OFF + 128 <= LDS_BYTES, "LDS map");

struct Args { const float* in[21]; const int* ptab; float* out; unsigned char* ws; int ph_lo, ph_hi; };

__global__ void __launch_bounds__(NWAVES * 64, 2) mk_fwd(Args args) {
    extern __shared__ __attribute__((aligned(16))) unsigned char lds[];
    const int tid = threadIdx.x, lane = tid & 63, wave = __builtin_amdgcn_readfirstlane(tid >> 6);
    const int G = gridDim.x, bx = blockIdx.x;
    volatile LAS unsigned* MISC = (volatile LAS unsigned*)((LAS unsigned char*)lds + MISC_OFF);
    unsigned char* ws = args.ws;
    gu32* ctl = (gu32*)(ws + WS_CTL);
    for (int u = tid; u < (LDS_BYTES - LDSCTL_OFF) / 4; u += NWAVES * 64) ((LAS unsigned*)((LAS unsigned char*)lds + LDSCTL_OFF))[u] = 0u;
    __syncthreads();
    XcdBarrier bar; bar.bar = (unsigned*)(ctl + CW_BAR); bar.x = 0; bar.st = nullptr;
    if (N_LAUNCHES == 1) bar = xcd_barrier_post((unsigned*)(ctl + CW_BAR), MISC + 8);
#ifndef BAR_REPS
#define BAR_REPS 1
#endif
#define GRID_BAR() do { if (N_LAUNCHES == 1) { for (int br_ = 0; br_ < BAR_REPS; ++br_) xcd_barrier(bar); } } while (0)
    const int lo = args.ph_lo, hi = args.ph_hi;
#ifndef PHASE_MASK
#define PHASE_MASK 0x1ff
#endif
#define IN(k) (((PHASE_MASK >> (k)) & 1) && lo <= (k) && (k) < hi)
#define BOTH(k) (IN(k) && IN((k) + 1))
#ifndef DBL_MASK
#define DBL_MASK 0
#endif
#define NREP(k) (((DBL_MASK >> (k)) & 1) ? 2 : 1)
    const float* x_p = args.in[0]; const float* x_s = args.in[1]; const float* cache_k = args.in[2]; const float* cache_v = args.in[3]; const float* state = args.in[4];
    const float* w_in = args.in[6]; const float* w_out = args.in[7]; const float* lbp = args.in[8]; const float* rgn = args.in[9];
    const float* lq1 = args.in[10]; const float* lk1 = args.in[11]; const float* lq2 = args.in[12]; const float* lk2 = args.in[13]; const float* subln = args.in[14];
    const float* n_mix = args.in[15]; const float* n_ffn = args.in[16]; const float* w_gate = args.in[17]; const float* w_up = args.in[18]; const float* w_down = args.in[19]; const float* n_fin = args.in[20];
    const int* ptab = args.ptab; float* out = args.out;
    bf16* Win_t = (bf16*)(ws + WS_WIN); bf16* Wout_t = (bf16*)(ws + WS_WOUT); bf16* Wgu_t = (bf16*)(ws + WS_WGU); bf16* Wd_t = (bf16*)(ws + WS_WD);
    float* PSs = (float*)(ws + WS_PSS); float* PS1 = (float*)(ws + WS_PS1); float* PS1s = (float*)(ws + WS_PS1S); float* DEC = (float*)(ws + WS_DEC);
    float* PML = (float*)(ws + WS_PML); float* PO = (float*)(ws + WS_PO);
    bf16* XN = (bf16*)(ws + WS_XN); bf16* QS = (bf16*)(ws + WS_QS); bf16* VR = (bf16*)(ws + WS_VR); bf16* GS = (bf16*)(ws + WS_GS);
    bf16* QA = (bf16*)(ws + WS_QA); bf16* KA = (bf16*)(ws + WS_KA); bf16* VA = (bf16*)(ws + WS_VA); float* Gl = (float*)(ws + WS_G);
    bf16* QBg = (bf16*)(ws + WS_QB); float* OI = (float*)(ws + WS_OI); float* KVT = (float*)(ws + WS_KVT); bf16* ST = (bf16*)(ws + WS_ST);
    bf16* MRG = (bf16*)(ws + WS_MRG); float* X1 = (float*)(ws + WS_X1); bf16* XB = (bf16*)(ws + WS_XB); bf16* Hb = (bf16*)(ws + WS_H);

    if (IN(0)) { _Pragma("unroll") for (int rep = 0; rep < NREP(0); ++rep) {
        float* scr = (float*)(lds + RING_OFF + wave * 16384);
        const int gw = bx * NWAVES + wave, NGW = G * NWAVES;
        constexpr int I_IN = (DM / 64) * (DIN / 32), I_OUT = (DM / 64) * (DM / 32), I_G = (DM / 64) * (DFF / 32), I_D = (DFF / 64) * (DM / 32);
        constexpr int NITEMS = I_IN + I_OUT + 2 * I_G + I_D;
        for (int it = gw; it < NITEMS; it += NGW) {
            int r = it;
            if (r < I_IN) { p0_transpose_item<0>(w_in, DM, DIN, Win_t, nullptr, scr, r, lane); continue; } r -= I_IN;
            if (r < I_OUT) { p0_transpose_item<0>(w_out, DM, DM, Wout_t, nullptr, scr, r, lane); continue; } r -= I_OUT;
            if (r < I_G) { p0_transpose_item<1>(w_gate, DM, DFF, Wgu_t, n_ffn, scr, r, lane); continue; } r -= I_G;
            if (r < I_G) { p0_transpose_item<2>(w_up, DM, DFF, Wgu_t, n_ffn, scr, r, lane); continue; } r -= I_G;
            p0_transpose_item<0>(w_down, DFF, DM, Wd_t, nullptr, scr, r, lane);
        }
        for (int m = gw; m < MT; m += NGW) rms_row_to_bf16(m < MP ? x_p + (size_t)m * DM : x_s + (size_t)(m - MP) * DM, n_mix, XN + (size_t)m * DM, lane);
        __syncthreads(); }
        if (BOTH(0)) GRID_BAR();
    }
    if (IN(1)) { _Pragma("unroll") for (int rep = 0; rep < NREP(1); ++rep) {
        { pg8::Gemm g{XN, Win_t, MP, DIN, DM}; pg8::StaticOrder S; S.init(MP, DIN, G, bx);
          pg8::EpiInProj E{QS, VR, GS, QA, KA, VA, Gl, out + O_KP, out + O_VP, lbp};
          pg8::gemm_phase<pg8::EpiInProj, pg8::StaticOrder, true, true>((LAS unsigned char*)lds + RING_OFF, g, S, E); }
        if (bx >= G / 2) {
            for (int t = bx - G / 2; t < DIN / 16; t += G / 2) { const int n0 = t * 16;
                const f32x4 acc = mini_tile<DM>(XN + (size_t)MP * DM, Win_t + (size_t)(n0 + (lane & 15)) * DM, wave, lane);
                const int c = lane & 15, q = lane >> 4;
#pragma unroll
                for (int i = 0; i < 4; ++i) { const int row = 16 * wave + 4 * q + i; const float v = acc[i];
                    PSs[(size_t)row * DIN + n0 + c] = v;
                    if (n0 >= 2560 && n0 < 3072) out[O_KS + (size_t)row * 512 + (n0 - 2560) + c] = v;
                    if (n0 >= 3072) out[O_VS + (size_t)row * 512 + (n0 - 3072) + c] = v; } }
        } }
        if (BOTH(1)) GRID_BAR();
    }
    if (IN(2)) {
        for (int rep = 0; rep < NREP(9); ++rep) for (int u = bx; u < NHU; u += G) hg::h1_unit(lds + RING_OFF, u, QS, Gl, VR, QBg, KVT, DEC, OI, tid, wave, lane);
        __syncthreads();
        { att::Consts C; const float s1 = wave_sum(lq1[lane] * lk1[lane]), s2 = wave_sum(lq2[lane] * lk2[lane]);
          C.lam = __builtin_bit_cast(float, __builtin_amdgcn_readfirstlane(__builtin_bit_cast(int, fexp(s1) - fexp(s2) + LAM_INIT))); C.oscale = 1.0f - LAM_INIT; C.subln = subln;
          if ((bx & 7) < 4) { for (int rep = 0; rep < NREP(11); ++rep) for (int u = bx * NWAVES + wave; u < MS * NPAGES; u += G * NWAVES) dec::partial_wave(u, cache_k, cache_v, ptab, PSs, PML, PO, lane); }
          att::attn_phase((char*)lds + RING_OFF, QA, KA, VA, MRG, C, G, bx);
          if ((bx & 7) >= 4) { for (int rep = 0; rep < NREP(11); ++rep) for (int u = bx * NWAVES + wave; u < MS * NPAGES; u += G * NWAVES) dec::partial_wave(u, cache_k, cache_v, ptab, PSs, PML, PO, lane); } }
        if (BOTH(2)) GRID_BAR();
    }
    if (IN(3)) { _Pragma("unroll") for (int rep = 0; rep < NREP(3); ++rep) {
        for (int idx = bx * 512 + tid; idx < 8 * 16384; idx += G * 512) hg::h2_scan(idx, KVT, DEC, ST, out + O_SP);
        { const float s1 = wave_sum(lq1[lane] * lk1[lane]), s2 = wave_sum(lq2[lane] * lk2[lane]); const float lam = fexp(s1) - fexp(s2) + LAM_INIT;
          for (int i = bx; i < MS; i += G) dec::combine_item(lds + RING_OFF, i, PSs, PML, PO, subln, lam, MRG + (size_t)MP * DM, tid, wave, lane); }
        for (int u = bx; u < MS * 4; u += G) dec::recurrent_unit(lds + RING_OFF, u, PSs, state, lbp, rgn, out + O_SS, MRG + (size_t)MP * DM, tid, wave, lane); }
        if (BOTH(3)) GRID_BAR();
    }
    if (IN(4)) {
        for (int rep = 0; rep < NREP(4); ++rep) for (int u = bx; u < NHU; u += G) hg::h3_unit(lds + RING_OFF, u, QBg, ST, OI, GS, rgn, MRG, tid, wave, lane);
        if (BOTH(4)) GRID_BAR();
    }
    if (IN(5)) { _Pragma("unroll") for (int rep = 0; rep < NREP(5); ++rep) {
        { pg8::Gemm g{MRG, Wout_t, MP, DM, DM}; pg8::StaticOrder S; S.init(MP, DM, G, bx);
          pg8::EpiWout E{x_p, X1, XB, PS1};
          pg8::gemm_phase<pg8::EpiWout, pg8::StaticOrder, true, true>((LAS unsigned char*)lds + RING_OFF, g, S, E); }
        for (int t = bx; t < DM / 16; t += G) { const int n0 = t * 16;
            const f32x4 acc = mini_tile<DM>(MRG + (size_t)MP * DM, Wout_t + (size_t)(n0 + (lane & 15)) * DM, wave, lane);
            const int c = lane & 15, q = lane >> 4;
#pragma unroll
            for (int i = 0; i < 4; ++i) { const int row = 16 * wave + 4 * q + i; const float v = x_s[(size_t)row * DM + n0 + c] + acc[i];
                X1[(size_t)(MP + row) * DM + n0 + c] = v; XB[(size_t)(MP + row) * DM + n0 + c] = (unsigned short)f2bf(v);
                float ss = v * v; ss += __shfl_xor(ss, 1); ss += __shfl_xor(ss, 2); ss += __shfl_xor(ss, 4); ss += __shfl_xor(ss, 8);
                if (c == 0) PS1s[row * 64 + t] = ss; } } }
        if (BOTH(5)) GRID_BAR();
    }
    if (IN(6)) { _Pragma("unroll") for (int rep = 0; rep < NREP(6); ++rep) {
        { pg8::Gemm g{XB, Wgu_t, MP, NGU, DM}; pg8::StaticOrder S; S.init(MP, NGU, G, bx);
          pg8::EpiGateUp E{PS1, Hb};
          pg8::gemm_phase<pg8::EpiGateUp, pg8::StaticOrder, true, true>((LAS unsigned char*)lds + RING_OFF, g, S, E); }
        if (bx >= G / 2) {
            float* RSTD = (float*)(lds + RING_OFF);
            if (tid < MS) { float s = 0.f;
#pragma unroll
                for (int j = 0; j < 16; ++j) { const f32x4 p = *(const f32x4*)(PS1s + tid * 64 + 4 * j); s += (p[0] + p[1]) + (p[2] + p[3]); }
                RSTD[tid] = __builtin_amdgcn_rsqf(s * (1.0f / 1024.0f) + EPS); }
            __syncthreads();
            for (int t = bx - G / 2; t < DFF / 16; t += G / 2) { const int f0 = t * 16, f = f0 + (lane & 15), grow = (f >> 2) * 8 + (f & 3);
                const f32x4 ag = mini_tile<DM>(XB + (size_t)MP * DM, Wgu_t + (size_t)grow * DM, wave, lane);
                const f32x4 au = mini_tile<DM>(XB + (size_t)MP * DM, Wgu_t + (size_t)(grow + 4) * DM, wave, lane);
                const int c = lane & 15, q = lane >> 4;
#pragma unroll
                for (int i = 0; i < 4; ++i) { const int row = 16 * wave + 4 * q + i; const float rs = RSTD[row];
                    Hb[(size_t)(MP + row) * DFF + f0 + c] = (unsigned short)f2bf(siluf(ag[i] * rs) * (au[i] * rs)); } }
            __syncthreads();
        } }
        if (BOTH(6)) GRID_BAR();
    }
    if (IN(7)) { _Pragma("unroll") for (int rep = 0; rep < NREP(7); ++rep) {
        { pg8::Gemm g{Hb, Wd_t, MP, DM, DFF}; pg8::StaticOrder S; S.init(MP, DM, G, bx);
          pg8::EpiDown E{X1, out + O_Y};
          pg8::gemm_phase<pg8::EpiDown, pg8::StaticOrder, true, true>((LAS unsigned char*)lds + RING_OFF, g, S, E); }
        for (int t = bx; t < DM / 16; t += G) { const int n0 = t * 16;
            const f32x4 acc = mini_tile<DFF>(Hb + (size_t)MP * DFF, Wd_t + (size_t)(n0 + (lane & 15)) * DFF, wave, lane);
            const int c = lane & 15, q = lane >> 4;
#pragma unroll
            for (int i = 0; i < 4; ++i) { const int row = 16 * wave + 4 * q + i;
                out[O_YS + (size_t)row * DM + n0 + c] = X1[(size_t)(MP + row) * DM + n0 + c] + acc[i]; } } }
        if (BOTH(7)) GRID_BAR();
    }
    if (IN(8)) {
        const int gw = bx * NWAVES + wave, NGW = G * NWAVES;
        for (int m = gw; m < MT; m += NGW) rms_row_inplace(m < MP ? out + O_Y + (size_t)m * DM : out + O_YS + (size_t)(m - MP) * DM, n_fin, lane);
    }
#undef IN
#undef BOTH
#undef GRID_BAR
}

extern "C" void kernel_launch(void* const* d_in, const int* in_sizes, int n_in, void* d_out, int out_size, void* d_ws, size_t ws_size, hipStream_t stream) {
    static int grid = 0;
    if (grid == 0) {
        if (n_in != 21 || in_sizes[0] != MP * DM || (size_t)out_size != O_END || ws_size < WS_END) {
            fprintf(stderr, "kernel_launch: unexpected shapes (n_in %d, in0 %d, out %d, ws %zu); nothing launched\n", n_in, n_in > 0 ? in_sizes[0] : -1, out_size, ws_size); grid = -1; return; }
        int dev = 0, cus = 0, per_cu = 0;
        if (hipGetDevice(&dev) != hipSuccess || hipDeviceGetAttribute(&cus, hipDeviceAttributeMultiprocessorCount, dev) != hipSuccess) { grid = -1; return; }
        if (hipFuncSetAttribute((const void*)mk_fwd, hipFuncAttributeMaxDynamicSharedMemorySize, LDS_BYTES) != hipSuccess) { fprintf(stderr, "kernel_launch: hipFuncSetAttribute failed\n"); grid = -1; return; }
        if (hipOccupancyMaxActiveBlocksPerMultiprocessor(&per_cu, (const void*)mk_fwd, NWAVES * 64, LDS_BYTES) != hipSuccess || per_cu < 1)
            fprintf(stderr, "kernel_launch: note: occupancy query reports %d workgroups per CU\n", per_cu);
        (void)hipGetLastError();
        grid = cus;
        if (grid > 256) grid = 256;
        grid &= ~7;
    }
    if (grid <= 0) return;
    (void)hipMemsetAsync((char*)d_ws + WS_CTL, 0, CTL_ZERO_BYTES, stream);
    Args a{};
    for (int i = 0; i < 21; ++i) a.in[i] = (const float*)d_in[i];
    a.ptab = (const int*)d_in[5]; a.out = (float*)d_out; a.ws = (unsigned char*)d_ws;
    if (N_LAUNCHES == 1) { a.ph_lo = 0; a.ph_hi = N_PHASES; hipLaunchKernelGGL(mk_fwd, dim3(grid), dim3(NWAVES * 64), LDS_BYTES, stream, a); }
    else for (int p = 0; p < N_PHASES; ++p) { a.ph_lo = p; a.ph_hi = p + 1; hipLaunchKernelGGL(mk_fwd, dim3(grid), dim3(NWAVES * 64), LDS_BYTES, stream, a); }
    const hipError_t le = hipPeekAtLastError();
    if (le != hipSuccess) fprintf(stderr, "kernel_launch: launch failed: %s\n", hipGetErrorName(le));
}
```

```cpp
#include <hip/hip_runtime.h>
#include <hip/hip_bf16.h>
#include <cstdio>
#include <cstdint>

constexpr int DM = 1024, NBATCH = 2, SEQ = 8192, MP = NBATCH * SEQ, MS = 128, MT = MP + MS;
constexpr int DIN = 3584, DFF = 2816, NGU = 2 * DFF;
constexpr int NPAGES = 16, PAGE = 128;
constexpr int CH = 64, NCH = SEQ / CH, NHU = NBATCH * 4 * NCH;
constexpr float EPS = 1e-6f;
constexpr float LOG2E = 1.4426950408889634f, LN2 = 0.6931471805599453f;
constexpr float LAM_INIT = 0.2f;

#define GAS __attribute__((address_space(1)))
#define LAS __attribute__((address_space(3)))
typedef unsigned short bf16;
typedef unsigned v4u __attribute__((ext_vector_type(4)));
typedef unsigned v2u __attribute__((ext_vector_type(2)));
typedef float f32x4 __attribute__((ext_vector_type(4)));
typedef float f32x16 __attribute__((ext_vector_type(16)));
typedef short bf16x8 __attribute__((ext_vector_type(8)));
typedef GAS unsigned gu32;
#define RLX_AGENT __ATOMIC_RELAXED, __HIP_MEMORY_SCOPE_AGENT
#define LDS_WAIT() asm volatile("s_waitcnt lgkmcnt(0)" ::: "memory")
#define VM_WAIT() asm volatile("s_waitcnt vmcnt(0)" ::: "memory")
__device__ __forceinline__ unsigned f2bf(float f) { unsigned u = __builtin_bit_cast(unsigned, f); return (u + 0x7fffu + ((u >> 16) & 1u)) >> 16; }
__device__ __forceinline__ unsigned pk2(float lo, float hi) { return f2bf(lo) | (f2bf(hi) << 16); }
__device__ __forceinline__ float bf2f(unsigned short b) { return __builtin_bit_cast(float, (unsigned)b << 16); }
__device__ __forceinline__ float sigm(float x) { return __builtin_amdgcn_rcpf(1.0f + __builtin_amdgcn_exp2f(-LOG2E * x)); }
__device__ __forceinline__ float siluf(float x) { return x * sigm(x); }
__device__ __forceinline__ float fexp(float x) { return __builtin_amdgcn_exp2f(LOG2E * x); }
__device__ __forceinline__ float wave_sum(float v) {
#pragma unroll
    for (int o = 1; o < 64; o <<= 1) v += __shfl_xor(v, o);
    return v;
}
__device__ __forceinline__ float wave_max(float v) {
#pragma unroll
    for (int o = 1; o < 64; o <<= 1) v = fmaxf(v, __shfl_xor(v, o));
    return v;
}
namespace pg8 {
#define PG8_LAS __attribute__((address_space(3)))
typedef unsigned short bf16_t;
typedef short bf16x8 __attribute__((ext_vector_type(8)));
typedef float f32x4 __attribute__((ext_vector_type(4)));
typedef unsigned u32x4 __attribute__((ext_vector_type(4)));
constexpr int BM = 256, BK = 64, HALF = 128, HTB = HALF * BK * 2  , STAGE_BYTES = 8 * HTB, NXCD = 8, WGM = 8;

__host__ __device__ __forceinline__ int lds_byte(int r, int c) { const int st = (r >> 4) * 2 + (c >> 5), rr = r & 15, cc = c & 31, ob = rr * 64 + cc * 2; return st * 1024 + (ob ^ (((ob >> 9) & 1) << 5)); }
__host__ __device__ __forceinline__ void stage_rc(int b, int& R, int& C) { const int st = b / 1024, sb = b % 1024, swz = sb ^ (((sb >> 9) & 1) << 5); R = (st >> 1) * 16 + swz / 64; C = (st & 1) * 32 + (swz % 64) / 2; }
__host__ __device__ __forceinline__ int perm32(int rho) { const int n = rho >> 4, i = rho & 15; return 8 * (i >> 2) + 4 * n + (i & 3); }

struct Unit { int pm, pn; };
struct Gemm { const bf16_t* A; const bf16_t* Bt; int M, N, K; };

struct StaticOrder {
    int nM, nN, nwg, G, c;
    __host__ __device__ void init(int M, int N, int G_, int c_) { nM = M / BM; nN = N / BM; nwg = nM * nN; G = G_; c = c_; }
    __host__ __device__ bool next(int i, Unit& u) const {
        const long L = (long)i * G + c; if (L >= nwg) return false;
        int wgid = (int)L; { const int q = nwg / NXCD, r = nwg % NXCD, xcd = wgid % NXCD, off = wgid / NXCD; wgid = (xcd < r ? xcd * (q + 1) : r * (q + 1) + (xcd - r) * q) + off; }
        const int nig = WGM * nN, gid = wgid / nig, fm = gid * WGM, gsz = (nM - fm) < WGM ? (nM - fm) : WGM;
        u.pm = fm + ((wgid % nig) % gsz); u.pn = (wgid % nig) / gsz; return true;
    }
    __device__ __forceinline__ void a_ready(const Unit&) const {}
    __device__ __forceinline__ void done(const Unit&) const {}
};

__device__ __forceinline__ unsigned cvt_pk_bf16(float lo, float hi) { unsigned r; asm volatile("v_cvt_pk_bf16_f32 %0, %1, %2" : "=v"(r) : "v"(lo), "v"(hi)); return r; }
typedef float f32x2 __attribute__((ext_vector_type(2)));
typedef unsigned u32x2 __attribute__((ext_vector_type(2)));
struct EpiInProj {
    static constexpr bool PERM = true, AFTER_DRAIN = false;
    bf16_t *QS, *VR, *GS, *QA, *KA, *VA; float* G; float* kout; float* vout; const float* lbp;
    __device__ __forceinline__ void operator()(const f32x4 (&acc)[2][2][4][2], const Unit& u, int wr, int wc, int fr, int fq) const {
        const int grp = u.pn >> 1;
        const int cb = (u.pn & 1) * 256 + wc * 32 + 8 * fq;
        const int row0 = u.pm * BM + wr * 64 + fr;
        if (grp == 1) {
            float lb[2][8];
#pragma unroll
            for (int bj = 0; bj < 2; ++bj)
#pragma unroll
                for (int e = 0; e < 8; ++e) { const int c = cb + bj * HALF + e; lb[bj][e] = ::sigm(lbp[c] - lbp[512 + c]); }
#pragma unroll
            for (int ai = 0; ai < 2; ++ai)
#pragma unroll
                for (int m = 0; m < 4; ++m) { const size_t row = (size_t)(row0 + ai * HALF + m * 16);
#pragma unroll
                    for (int bj = 0; bj < 2; ++bj) { const f32x4 v0 = acc[ai][bj][m][0], v1 = acc[ai][bj][m][1]; f32x4 g0, g1;
#pragma unroll
                        for (int e = 0; e < 4; ++e) { const float f0 = lb[bj][e] + (1.0f - lb[bj][e]) * ::sigm(v0[e]), f1 = lb[bj][4 + e] + (1.0f - lb[bj][4 + e]) * ::sigm(v1[e]);
                            g0[e] = __builtin_amdgcn_logf(f0) * LN2; g1[e] = __builtin_amdgcn_logf(f1) * LN2; }
                        float* gp = G + row * 512 + cb + bj * HALF; *(f32x4*)gp = g0; *(f32x4*)(gp + 4) = g1; } }
        } else {
            bf16_t* dst = grp == 0 ? QS : grp == 2 ? VR : grp == 3 ? GS : grp == 4 ? QA : grp == 5 ? KA : VA;
            float* fo = grp == 5 ? kout : grp == 6 ? vout : nullptr;
            const bool act = (grp == 0 || grp == 3);
#pragma unroll
            for (int ai = 0; ai < 2; ++ai)
#pragma unroll
                for (int m = 0; m < 4; ++m) { const size_t row = (size_t)(row0 + ai * HALF + m * 16);
#pragma unroll
                    for (int bj = 0; bj < 2; ++bj) { f32x4 v0 = acc[ai][bj][m][0], v1 = acc[ai][bj][m][1];
                        const size_t off = row * 512 + cb + bj * HALF;
                        if (fo) { *(f32x4*)(fo + off) = v0; *(f32x4*)(fo + off + 4) = v1; }
                        if (act) {
#pragma unroll
                            for (int e = 0; e < 4; ++e) { v0[e] = ::siluf(v0[e]); v1[e] = ::siluf(v1[e]); } }
                        u32x4 w; w.x = cvt_pk_bf16(v0[0], v0[1]); w.y = cvt_pk_bf16(v0[2], v0[3]); w.z = cvt_pk_bf16(v1[0], v1[1]); w.w = cvt_pk_bf16(v1[2], v1[3]);
                        *(u32x4*)(dst + off) = w; } }
        }
    }
};
struct EpiWout {
    static constexpr bool PERM = false, AFTER_DRAIN = false;
    const float* X; float* X1; bf16_t* XB; float* PS1;
    __device__ __forceinline__ void operator()(const f32x4 (&acc)[2][2][4][2], const Unit& u, int wr, int wc, int fr, int fq) const {
        const int row0 = u.pm * BM + wr * 64 + fr, col0 = u.pn * BM + wc * 32 + 4 * fq;
#pragma unroll
        for (int ai = 0; ai < 2; ++ai)
#pragma unroll
            for (int m = 0; m < 4; ++m) { const size_t row = (size_t)(row0 + ai * HALF + m * 16); float ss = 0.f;
#pragma unroll
                for (int bj = 0; bj < 2; ++bj)
#pragma unroll
                    for (int n = 0; n < 2; ++n) { const size_t off = row * 1024 + col0 + bj * HALF + n * 16;
                        const f32x4 v = *(const f32x4*)(X + off) + acc[ai][bj][m][n]; *(f32x4*)(X1 + off) = v;
                        u32x2 w; w.x = cvt_pk_bf16(v[0], v[1]); w.y = cvt_pk_bf16(v[2], v[3]); *(u32x2*)(XB + off) = w;
                        ss += (v[0] * v[0] + v[1] * v[1]) + (v[2] * v[2] + v[3] * v[3]); }
                ss += __shfl_xor(ss, 16); ss += __shfl_xor(ss, 32);
                if (fq == 0) PS1[row * 16 + u.pn * 4 + wc] = ss; }
    }
};
struct EpiGateUp {
    static constexpr bool PERM = true, AFTER_DRAIN = false;
    const float* PS1; bf16_t* H;
    __device__ __forceinline__ void operator()(const f32x4 (&acc)[2][2][4][2], const Unit& u, int wr, int wc, int fr, int fq) const {
        const int row0 = u.pm * BM + wr * 64 + fr, f0 = (u.pn * BM + wc * 32 + 8 * fq) >> 1;
#pragma unroll
        for (int ai = 0; ai < 2; ++ai)
#pragma unroll
            for (int m = 0; m < 4; ++m) { const size_t row = (size_t)(row0 + ai * HALF + m * 16);
                const f32x4 p0 = *(const f32x4*)(PS1 + row * 16), p1 = *(const f32x4*)(PS1 + row * 16 + 4), p2 = *(const f32x4*)(PS1 + row * 16 + 8), p3 = *(const f32x4*)(PS1 + row * 16 + 12);
                const f32x4 ps = (p0 + p1) + (p2 + p3);
                const float rstd = __builtin_amdgcn_rsqf(((ps[0] + ps[1]) + (ps[2] + ps[3])) * (1.0f / 1024.0f) + EPS);
#pragma unroll
                for (int bj = 0; bj < 2; ++bj) { const f32x4 g = acc[ai][bj][m][0] * rstd, uu = acc[ai][bj][m][1] * rstd;
                    u32x2 w; w.x = cvt_pk_bf16(::siluf(g[0]) * uu[0], ::siluf(g[1]) * uu[1]); w.y = cvt_pk_bf16(::siluf(g[2]) * uu[2], ::siluf(g[3]) * uu[3]);
                    *(u32x2*)(H + row * 2816 + f0 + bj * 64) = w; } }
    }
};
struct EpiDown {
    static constexpr bool PERM = false, AFTER_DRAIN = false;
    const float* X1; float* OUT;
    __device__ __forceinline__ void operator()(const f32x4 (&acc)[2][2][4][2], const Unit& u, int wr, int wc, int fr, int fq) const {
        const int row0 = u.pm * BM + wr * 64 + fr, col0 = u.pn * BM + wc * 32 + 4 * fq;
#pragma unroll
        for (int ai = 0; ai < 2; ++ai)
#pragma unroll
            for (int m = 0; m < 4; ++m) { const size_t row = (size_t)(row0 + ai * HALF + m * 16);
#pragma unroll
                for (int bj = 0; bj < 2; ++bj)
#pragma unroll
                    for (int n = 0; n < 2; ++n) { const size_t off = row * 1024 + col0 + bj * HALF + n * 16;
                        *(f32x4*)(OUT + off) = *(const f32x4*)(X1 + off) + acc[ai][bj][m][n]; } }
    }
};
template <class Epi, class Sched, bool ALIGN_EPI = false, bool SP2 = false>
__device__ __forceinline__ void gemm_phase(PG8_LAS unsigned char* lds, const Gemm g, const Sched& S, const Epi& E) {
    const int tid = threadIdx.x, wid = __builtin_amdgcn_readfirstlane(tid >> 6), lane = tid & 63, wr = wid >> 2, wc = wid & 3, fr = lane & 15, fq = lane >> 4;
    const int K = g.K, nt = K / BK;
    unsigned voffA[2], voffB[2];
#pragma unroll
    for (int i = 0; i < 2; ++i) { int R, C; stage_rc(tid * 16 + i * 8192, R, C); const int Rb = Epi::PERM ? ((R & ~31) + perm32(R & 31)) : R;
        voffA[i] = (unsigned)(R * K + C) * 2u; voffB[i] = (unsigned)(Rb * K + C) * 2u; }
    const size_t kstep = (size_t)(BK * 2);
    const size_t hstep = (size_t)HALF * K * 2;
    const size_t tstep = 2 * hstep;
    const unsigned ldsw = (unsigned)wid * 1024u;
    const int aoff = lds_byte(wr * 64 + fr, fq * 8), boff = lds_byte(wc * 32 + fr, fq * 8);
#define PG8_SA(b, h) (((b) * 2 + (h)) * HTB)
#define PG8_SB(b, h) ((4 + (b) * 2 + (h)) * HTB)
#define PG8_STAGE(bufoff, gbase, voff) do { _Pragma("unroll") for (int _i = 0; _i < 2; ++_i) \
        __builtin_amdgcn_global_load_lds((const unsigned*)((const char*)(gbase) + (voff)[_i]), (PG8_LAS unsigned*)(lds + (bufoff) + ldsw + _i * 8192), 16, 0, 0); } while (0)
#define PG8_LDA(dst, b, h) do { _Pragma("unroll") for (int m = 0; m < 4; ++m) _Pragma("unroll") for (int k = 0; k < 2; ++k) dst[m][k] = *(const PG8_LAS bf16x8*)(lds + PG8_SA(b, h) + aoff + m * 2048 + k * 1024); } while (0)
#define PG8_LDB(dst, b, h) do { _Pragma("unroll") for (int n = 0; n < 2; ++n) _Pragma("unroll") for (int k = 0; k < 2; ++k) dst[n][k] = *(const PG8_LAS bf16x8*)(lds + PG8_SB(b, h) + boff + n * 2048 + k * 1024); } while (0)
#define PG8_MMA(ai, bj, At, Bt) do { __builtin_amdgcn_s_setprio(1); _Pragma("unroll") for (int m = 0; m < 4; ++m) _Pragma("unroll") for (int n = 0; n < 2; ++n) _Pragma("unroll") for (int k = 0; k < 2; ++k) \
        acc[ai][bj][m][n] = __builtin_amdgcn_mfma_f32_16x16x32_bf16(Bt[n][k], At[m][k], acc[ai][bj][m][n], 0, 0, 0); __builtin_amdgcn_s_setprio(0); } while (0)
#define PG8_WAIT_V(n) asm volatile("s_waitcnt vmcnt(" #n ")" ::: "memory")
#define PG8_WAIT_L(n) asm volatile("s_waitcnt lgkmcnt(" #n ")" ::: "memory")
#define PG8_BAR __builtin_amdgcn_s_barrier()
#define PG8_SCHED __builtin_amdgcn_sched_barrier(0)
    Unit cur, nxt; int ui = 0;
    if (!S.next(0, cur)) return;
    f32x4 acc[2][2][4][2];
#pragma unroll
    for (int a = 0; a < 2; ++a)
#pragma unroll
        for (int b = 0; b < 2; ++b)
#pragma unroll
            for (int m = 0; m < 4; ++m)
#pragma unroll
                for (int n = 0; n < 2; ++n) acc[a][b][m][n] = (f32x4){0.f, 0.f, 0.f, 0.f};
    bf16x8 At[4][2], B0[2][2], B1[2][2];
    const char* cA = (const char*)g.A + (size_t)cur.pm * tstep; const char* cB = (const char*)g.Bt + (size_t)cur.pn * tstep;
    S.a_ready(cur);
    if constexpr (SP2) {
        PG8_STAGE(PG8_SB(0, 0), cB, voffB); PG8_STAGE(PG8_SB(0, 1), cB + hstep, voffB); PG8_STAGE(PG8_SA(0, 0), cA, voffA); PG8_STAGE(PG8_SA(0, 1), cA + hstep, voffA);
        if (wr == 1) PG8_BAR;
        PG8_WAIT_V(2); PG8_BAR;
        PG8_STAGE(PG8_SB(1, 0), cB + kstep, voffB); PG8_STAGE(PG8_SA(1, 0), cA + kstep, voffA); PG8_STAGE(PG8_SB(1, 1), cB + hstep + kstep, voffB);
        PG8_WAIT_V(6); PG8_BAR;
    } else {
        PG8_STAGE(PG8_SB(0, 0), cB, voffB); PG8_STAGE(PG8_SA(0, 0), cA, voffA); PG8_STAGE(PG8_SB(0, 1), cB + hstep, voffB); PG8_STAGE(PG8_SA(0, 1), cA + hstep, voffA);
        if (wr == 1) PG8_BAR;
        PG8_WAIT_V(4); PG8_BAR;
        PG8_STAGE(PG8_SB(1, 0), cB + kstep, voffB); PG8_STAGE(PG8_SA(1, 0), cA + kstep, voffA); PG8_STAGE(PG8_SB(1, 1), cB + hstep + kstep, voffB);
        PG8_WAIT_V(6); PG8_BAR;
    }
    for (;;) {
        const bool has_next = S.next(ui + 1, nxt);
        const char* nA = has_next ? (const char*)g.A + (size_t)nxt.pm * tstep : cA; const char* nB = has_next ? (const char*)g.Bt + (size_t)nxt.pn * tstep : cB;
        for (int t = 0; t < nt; t += 2) {
            const bool last = (t == nt - 2);
            const char* a1 = cA + (size_t)(t + 1) * kstep;
            const char* a2 = last ? nA : cA + (size_t)(t + 2) * kstep; const char* b2 = last ? nB : cB + (size_t)(t + 2) * kstep;
            const char* a3 = a2 + kstep; const char* b3 = b2 + kstep;
            if (last && has_next) S.a_ready(nxt);
            if constexpr (SP2) {
            PG8_LDB(B0, 0, 0); PG8_LDB(B1, 0, 1); PG8_SCHED; PG8_LDA(At, 0, 0); PG8_STAGE(PG8_SA(1, 1), a1 + hstep, voffA);
            PG8_WAIT_V(8); PG8_WAIT_L(0); PG8_BAR; PG8_MMA(0, 0, At, B0); PG8_MMA(0, 1, At, B1); PG8_BAR; PG8_SCHED;
            PG8_LDA(At, 0, 1); PG8_STAGE(PG8_SB(0, 0), b2, voffB); PG8_STAGE(PG8_SB(0, 1), b2 + hstep, voffB); PG8_STAGE(PG8_SA(0, 0), a2, voffA);
            PG8_WAIT_V(8); PG8_WAIT_L(0); PG8_BAR; PG8_MMA(1, 0, At, B0); PG8_MMA(1, 1, At, B1); PG8_BAR; PG8_SCHED;
            PG8_LDB(B0, 1, 0); PG8_LDB(B1, 1, 1); PG8_SCHED; PG8_LDA(At, 1, 0); PG8_STAGE(PG8_SA(0, 1), a2 + hstep, voffA);
            PG8_WAIT_V(8); PG8_WAIT_L(0); PG8_BAR; PG8_MMA(0, 0, At, B0); PG8_MMA(0, 1, At, B1); PG8_BAR; PG8_SCHED;
            PG8_LDA(At, 1, 1); PG8_STAGE(PG8_SB(1, 0), b3, voffB); PG8_STAGE(PG8_SB(1, 1), b3 + hstep, voffB); PG8_STAGE(PG8_SA(1, 0), a3, voffA);
            PG8_WAIT_V(8); PG8_WAIT_L(0); PG8_BAR; PG8_MMA(1, 0, At, B0); PG8_MMA(1, 1, At, B1); PG8_BAR; PG8_SCHED;
            } else {
            PG8_LDB(B0, 0, 0); PG8_SCHED; PG8_LDA(At, 0, 0); PG8_STAGE(PG8_SA(1, 1), a1 + hstep, voffA);
            PG8_WAIT_L(8); PG8_BAR; PG8_WAIT_L(0); PG8_MMA(0, 0, At, B0); PG8_BAR; PG8_SCHED;
            PG8_LDB(B1, 0, 1); PG8_STAGE(PG8_SB(0, 0), b2, voffB);
            PG8_BAR; PG8_WAIT_L(0); PG8_MMA(0, 1, At, B1); PG8_BAR;
            PG8_LDA(At, 0, 1); PG8_STAGE(PG8_SA(0, 0), a2, voffA);
            PG8_BAR; PG8_WAIT_L(0); PG8_MMA(1, 0, At, B0); PG8_BAR; PG8_SCHED;
            PG8_STAGE(PG8_SB(0, 1), b2 + hstep, voffB);
            PG8_WAIT_V(6); PG8_BAR; PG8_MMA(1, 1, At, B1); PG8_BAR;
            PG8_LDB(B0, 1, 0); PG8_SCHED; PG8_LDA(At, 1, 0); PG8_STAGE(PG8_SA(0, 1), a2 + hstep, voffA);
            PG8_WAIT_L(8); PG8_BAR; PG8_WAIT_L(0); PG8_MMA(0, 0, At, B0); PG8_BAR; PG8_SCHED;
            PG8_LDB(B1, 1, 1); PG8_STAGE(PG8_SB(1, 0), b3, voffB);
            PG8_BAR; PG8_WAIT_L(0); PG8_MMA(0, 1, At, B1); PG8_BAR;
            PG8_LDA(At, 1, 1); PG8_STAGE(PG8_SA(1, 0), a3, voffA);
            PG8_BAR; PG8_WAIT_L(0); PG8_MMA(1, 0, At, B0); PG8_BAR; PG8_SCHED;
            PG8_STAGE(PG8_SB(1, 1), b3 + hstep, voffB);
            PG8_WAIT_V(6); PG8_BAR; PG8_MMA(1, 1, At, B1); PG8_BAR;
            }
        }
        if constexpr (ALIGN_EPI) { if (wr == 0) PG8_BAR; }
        if constexpr (!Epi::AFTER_DRAIN) { E(acc, cur, wr, wc, fr, fq); S.done(cur); }
        if (!has_next) break;
#pragma unroll
        for (int a = 0; a < 2; ++a)
#pragma unroll
            for (int b = 0; b < 2; ++b)
#pragma unroll
                for (int m = 0; m < 4; ++m)
#pragma unroll
                    for (int n = 0; n < 2; ++n) acc[a][b][m][n] = (f32x4){0.f, 0.f, 0.f, 0.f};
        cur = nxt; cA = nA; cB = nB; ++ui;
        if constexpr (ALIGN_EPI) { if (wr == 1) PG8_BAR; }
    }
    PG8_WAIT_V(0);
    if constexpr (!ALIGN_EPI) { if (wr == 0) PG8_BAR; }
    PG8_BAR;
    if constexpr (Epi::AFTER_DRAIN) { E.fused(acc, cur, wr, wc, fr, fq, lds, wid, lane); S.done(cur); }
#undef PG8_SA
#undef PG8_SB
#undef PG8_STAGE
#undef PG8_LDA
#undef PG8_LDB
#undef PG8_MMA
#undef PG8_WAIT_V
#undef PG8_WAIT_L
#undef PG8_BAR
#undef PG8_SCHED
}
}
namespace att {
typedef short s16x4 __attribute__((ext_vector_type(4)));
constexpr int NW = 8, QBLK = 32, KVBLK = 64, QB = 128, D = 128, PITCH = 512, OPITCH = 1024;
constexpr int SHM_V = KVBLK * D * 2, SHM_K = KVBLK * D * 2;
constexpr int LDS_WS = 2 * SHM_V + 2 * SHM_K, LDS_XCH = LDS_WS + NW * 64 * 4, LDS_BYTES = LDS_XCH + 4 * 32 * 128 * 4;
constexpr float SCALE = 0.125f, THR = 8.f;
constexpr unsigned WBIG = 0x40000000u;
#define KSWZ(row, colB) ((row) * 256 + ((colB) ^ (((row) & 7) << 4)))
#define SBAR() __builtin_amdgcn_sched_barrier(0)
__device__ __forceinline__ int v_st(int k, int c) { const int kk = (k & ~0xC) | ((k & 4) << 1) | ((k & 8) >> 1); return ((kk >> 3) * 4 + (c >> 5)) * 512 + ((kk & 7) * 32 + (c & 31)) * 2; }
__device__ __forceinline__ int v_rd_base(int lane) { return ((lane & 3) << 3) | (((lane >> 2) & 3) << 6) | (((lane >> 4) & 1) << 5) | (((lane >> 5) & 1) << 8); }
constexpr int v_rd_off(int d0, int ks, int half) { return d0 * 512 + ks * 4096 + half * 2048; }
__device__ __forceinline__ int crow(int r, int hi) { return (r & 3) + 8 * (r >> 2) + 4 * hi; }
__device__ __forceinline__ unsigned cvtpk(float lo, float hi) { unsigned r; asm volatile("v_cvt_pk_bf16_f32 %0, %1, %2" : "=v"(r) : "v"(lo), "v"(hi)); return r; }
__device__ __forceinline__ bf16x8 load8(const bf16* p) { return *reinterpret_cast<const bf16x8*>(p); }
__device__ __forceinline__ void mask_tile(f32x16& p0, f32x16& p1, int dq, unsigned W) {
    const float NEG = -__builtin_inff();
#pragma unroll
    for (int r = 0; r < 16; ++r) {
        const int c = (r & 3) + 8 * (r >> 2);
        if ((unsigned)(dq - c) >= W) p0[r] = NEG;
        if ((unsigned)(dq - c - 32) >= W) p1[r] = NEG;
    }
}
__device__ __forceinline__ void partialSM(f32x16& p0, f32x16& p1, float& m_reg, float& mn, float& alpha) {
    float pmax = p0[0];
#pragma unroll
    for (int r = 1; r < 16; ++r) pmax = fmaxf(pmax, p0[r]);
#pragma unroll
    for (int r = 0; r < 16; ++r) pmax = fmaxf(pmax, p1[r]);
    { auto rr = __builtin_amdgcn_permlane32_swap(__float_as_uint(pmax), __float_as_uint(pmax), false, false);
      pmax = fmaxf(__uint_as_float(rr[0]), __uint_as_float(rr[1])); }
    constexpr float C2 = 1.4426950408889634f * SCALE;
    if (__builtin_expect(__all((pmax - m_reg) * SCALE <= THR), 1)) { mn = m_reg; alpha = 1.f; }
    else { mn = fmaxf(m_reg, pmax); alpha = __builtin_amdgcn_exp2f((m_reg - mn) * C2); m_reg = mn; }
    const float mnL = -mn * C2;
#pragma unroll
    for (int r = 0; r < 16; ++r) p0[r] = fmaf(p0[r], C2, mnL);
#pragma unroll
    for (int r = 0; r < 16; ++r) p1[r] = fmaf(p1[r], C2, mnL);
#pragma unroll
    for (int r = 0; r < 16; ++r) p0[r] = __builtin_amdgcn_exp2f(p0[r]);
}
__device__ __forceinline__ void finishSM(f32x16& p0, f32x16& p1, float alpha, float& l_reg, bf16x8& pa0, bf16x8& pa1, bf16x8& pa2, bf16x8& pa3) {
#pragma unroll
    for (int r = 0; r < 16; ++r) p1[r] = __builtin_amdgcn_exp2f(p1[r]);
    float ps = 0;
#pragma unroll
    for (int r = 0; r < 16; ++r) ps += p0[r];
#pragma unroll
    for (int r = 0; r < 16; ++r) ps += p1[r];
    { auto rr = __builtin_amdgcn_permlane32_swap(__float_as_uint(ps), __float_as_uint(ps), false, false);
      ps = __uint_as_float(rr[0]) + __uint_as_float(rr[1]); }
    l_reg = l_reg * alpha + ps;
#define PK4(P, B_, OUT) do { unsigned a0 = cvtpk(P[B_+0], P[B_+1]), a1 = cvtpk(P[B_+2], P[B_+3]);                          \
        unsigned b0 = cvtpk(P[B_+4], P[B_+5]), b1 = cvtpk(P[B_+6], P[B_+7]);                                             \
        auto r0 = __builtin_amdgcn_permlane32_swap(a0, b0, false, false); auto r1 = __builtin_amdgcn_permlane32_swap(a1, b1, false, false); \
        v4u w = {r0[0], r1[0], r0[1], r1[1]}; OUT = *reinterpret_cast<bf16x8*>(&w); } while (0)
    PK4(p0, 0, pa0); PK4(p0, 8, pa1); PK4(p1, 0, pa2); PK4(p1, 8, pa3);
#undef PK4
}
template <int KB>
__device__ __forceinline__ void qkt(f32x16& p0, f32x16& p1, const char* K_lds, int r32, int hi, const bf16x8* qr, int kcolB) {
    p0 = f32x16{}; p1 = f32x16{};
#pragma unroll
    for (int d0 = 0; d0 < 4; ++d0) { const char* a = K_lds + KB * SHM_K + KSWZ(r32, (d0 * 16 + hi * 8) * 2 + kcolB);
        bf16x8 b0 = *reinterpret_cast<const bf16x8*>(a);
        bf16x8 b1 = *reinterpret_cast<const bf16x8*>(a + 32 * 256);
        p0 = __builtin_amdgcn_mfma_f32_32x32x16_bf16(b0, qr[d0], p0, 0, 0, 0);
        p1 = __builtin_amdgcn_mfma_f32_32x32x16_bf16(b1, qr[d0], p1, 0, 0, 0); }
}
template <int VB>
__device__ __forceinline__ void pv_tile(f32x16* o, int vb0, bf16x8 pa0, bf16x8 pa1, bf16x8 pa2, bf16x8 pa3) {
#define TRRD(dst, off) asm volatile("ds_read_b64_tr_b16 %0, %1 offset:%2" : "=&v"(dst) : "v"(vb0), "i"(off) : "memory")
#define PV_D0(d0) do { s16x4 l0, l1, l2, l3, h0, h1, h2, h3; constexpr int b_ = VB * SHM_V + v_rd_off(d0, 0, 0);     \
        TRRD(l0, b_); TRRD(h0, b_ + 2048); TRRD(l1, b_ + 4096); TRRD(h1, b_ + 6144); TRRD(l2, b_ + 8192); TRRD(h2, b_ + 10240); TRRD(l3, b_ + 12288); TRRD(h3, b_ + 14336); \
        asm volatile("s_waitcnt lgkmcnt(0)" ::: "memory"); SBAR();                 \
        o[d0] = __builtin_amdgcn_mfma_f32_32x32x16_bf16(pa0, (bf16x8){l0[0], l0[1], l0[2], l0[3], h0[0], h0[1], h0[2], h0[3]}, o[d0], 0, 0, 0);   \
        o[d0] = __builtin_amdgcn_mfma_f32_32x32x16_bf16(pa1, (bf16x8){l1[0], l1[1], l1[2], l1[3], h1[0], h1[1], h1[2], h1[3]}, o[d0], 0, 0, 0);   \
        o[d0] = __builtin_amdgcn_mfma_f32_32x32x16_bf16(pa2, (bf16x8){l2[0], l2[1], l2[2], l2[3], h2[0], h2[1], h2[2], h2[3]}, o[d0], 0, 0, 0);   \
        o[d0] = __builtin_amdgcn_mfma_f32_32x32x16_bf16(pa3, (bf16x8){l3[0], l3[1], l3[2], l3[3], h3[0], h3[1], h3[2], h3[3]}, o[d0], 0, 0, 0); } while (0)
    PV_D0(0); PV_D0(1); PV_D0(2); PV_D0(3);
#undef PV_D0
#undef TRRD
}
struct BlockRef { const bf16* Q; const bf16* K; const bf16* V; bf16* O; int P0; };
struct Seam { bf16x8 qr[4]; bf16x8 st_v0, st_v1, st_k0, st_k1; };
struct Consts { float lam, oscale; const float* subln; };
#define AROW(p, k0, rr) ((p) + (size_t)((k0) + (rr)) * PITCH + sc)
#define VMW() asm volatile("s_waitcnt vmcnt(0)" ::: "memory")
#define VMWN(n) asm volatile("s_waitcnt vmcnt(%0)" :: "i"(n) : "memory")
#define SLOAD_H(Kp, Vp, k0) do { S.st_v0 = load8(AROW(Vp, k0, sr)); S.st_v1 = load8(AROW(Vp, k0, 32 + sr));              \
                         S.st_k0 = load8(AROW(Kp, k0, sr)); S.st_k1 = load8(AROW(Kp, k0, 32 + sr)); } while (0)
#define SWRITE_HK(bf) do { *(bf16x8*)(K_lds + (bf) * SHM_K + kws) = S.st_k0; *(bf16x8*)(K_lds + (bf) * SHM_K + kws + 32 * 256) = S.st_k1; } while (0)
#define SWRITE_HV(bf) do { *(bf16x8*)(V_lds + (bf) * SHM_V + vst0) = S.st_v0; *(bf16x8*)(V_lds + (bf) * SHM_V + vst1) = S.st_v1; } while (0)
#define SWRITE_H(bf) do { SWRITE_HV(bf); SWRITE_HK(bf); } while (0)
__device__ __forceinline__ void prime(const BlockRef& cur, char* lds, Seam& S) {
    const int tid = threadIdx.x, wid = __builtin_amdgcn_readfirstlane(tid >> 6), lane = tid & 63, r32 = lane & 31, hi = lane >> 5;
    const int mw = wid >> 2, wq = wid & 3;
    const int sr = tid >> 4, sc = (tid & 15) * 8, kws = KSWZ(sr, sc * 2); char* K_lds = lds + 2 * SHM_V;
#pragma unroll
    for (int d0 = 0; d0 < 4; ++d0) S.qr[d0] = load8(cur.Q + (size_t)(wq * QBLK + r32) * PITCH + mw * 64 + d0 * 16 + hi * 8);
    SLOAD_H(cur.K, cur.V, 0); VMW(); SWRITE_HK(0);
    __syncthreads();
}
__device__ __forceinline__ void block(const BlockRef& cur, const BlockRef& nxt, char* lds, Seam& S, const Consts& C) {
    const int tid = threadIdx.x, wid = __builtin_amdgcn_readfirstlane(tid >> 6), lane = tid & 63, r32 = lane & 31, hi = lane >> 5;
    const int mw = wid >> 2, wq = wid & 3;
    const int NT = cur.P0 / KVBLK + 2;
    const int qlo = cur.P0 + wq * QBLK, qm = qlo + r32 - 4 * hi;
    char* V_lds = lds; char* K_lds = lds + 2 * SHM_V;
    float* ws = (float*)(lds + LDS_WS) + wid * 64; float* li_l = ws, * al_l = ws + 32;
    float m_reg = -1e30f, l_reg = 0; f32x16 o[4] = {};
    const int sr = tid >> 4, sc = (tid & 15) * 8, vst0 = v_st(sr, sc), vst1 = v_st(32 + sr, sc), kws = KSWZ(sr, sc * 2);
    const int vb0 = (int)(uintptr_t)V_lds + v_rd_base(lane);
    const int kcolB = mw * 128;
    const bf16* Kh = cur.K; const bf16* Vh = cur.V;
#define RESC(a) do { if (__any((a) < 1.f)) { if (hi == 0) al_l[r32] = (a); asm volatile("s_waitcnt lgkmcnt(0)" ::: "memory");              \
                     for (int d_ = 0; d_ < 4; ++d_) for (int r = 0; r < 16; ++r) o[d_][r] *= al_l[crow(r, hi)]; } } while (0)
#define KBASE(t) ((t) * KVBLK)
#define MASKT(P0_, P1_, t) do { const int kb_ = KBASE(t); if (kb_ + KVBLK - 1 > qlo) mask_tile(P0_, P1_, qm - kb_, WBIG); } while (0)
    constexpr int NQL = 4;
#define SEAM_K0() do { VMWN(NQL); SWRITE_HK(0); SBAR(); } while (0)
    f32x16 pA0, pA1, pB0, pB1; float mnA, mnB, alA, alB; bf16x8 pa0, pa1, pa2, pa3;
    SWRITE_HV(0); SBAR();
    if (NT > 1) { SLOAD_H(Kh, Vh, KBASE(1)); }
    SBAR(); qkt<0>(pA0, pA1, K_lds, r32, hi, S.qr, kcolB);
    MASKT(pA0, pA1, 0); partialSM(pA0, pA1, m_reg, mnA, alA);
    if (NT > 1) { VMW(); SWRITE_H(1); }
    __syncthreads();
#define HALF_STEP(PX0, PX1, mnX, alX, PY0, PY1, alY, t, KB, VB, SB) do {                                                      \
        SBAR(); qkt<KB>(PX0, PX1, K_lds, r32, hi, S.qr, kcolB);                                                               \
        finishSM(PY0, PY1, alY, l_reg, pa0, pa1, pa2, pa3); SBAR();                                                           \
        if ((t) + 1 < NT) { SLOAD_H(Kh, Vh, KBASE((t) + 1)); SBAR(); }                                                        \
        pv_tile<VB>(o, vb0, pa0, pa1, pa2, pa3); MASKT(PX0, PX1, (t)); partialSM(PX0, PX1, m_reg, mnX, alX);                  \
        __syncthreads();                                                                                                      \
        if ((t) + 1 < NT) { VMW(); SWRITE_H(SB); }                                                                            \
        RESC(alX); __syncthreads(); } while (0)
    for (int t = 1; t + 1 < NT; t += 2) {
        HALF_STEP(pB0, pB1, mnB, alB, pA0, pA1, alA, t, 1, 0, 0);
        HALF_STEP(pA0, pA1, mnA, alA, pB0, pB1, alB, t + 1, 0, 1, 1);
    }
    const bool even = (NT & 1) == 0;
    if (even) { SBAR(); qkt<1>(pB0, pB1, K_lds, r32, hi, S.qr, kcolB); SBAR(); }
    SLOAD_H(nxt.K, nxt.V, 0); SBAR();
#pragma unroll
    for (int d0 = 0; d0 < 4; ++d0) S.qr[d0] = load8(nxt.Q + (size_t)(wq * QBLK + r32) * PITCH + mw * 64 + d0 * 16 + hi * 8);
    SBAR();
    finishSM(pA0, pA1, alA, l_reg, pa0, pa1, pa2, pa3); SBAR();
    pv_tile<0>(o, vb0, pa0, pa1, pa2, pa3);
    if (even) { MASKT(pB0, pB1, NT - 1); partialSM(pB0, pB1, m_reg, mnB, alB); __syncthreads(); RESC(alB);
        finishSM(pB0, pB1, alB, l_reg, pa0, pa1, pa2, pa3); SBAR(); pv_tile<1>(o, vb0, pa0, pa1, pa2, pa3); }
    SBAR(); SEAM_K0();
    int r32e = r32, hie = hi; asm volatile("" : "+v"(r32e), "+v"(hie));
    if (hie == 0) li_l[r32e] = l_reg; asm volatile("s_waitcnt lgkmcnt(0)" ::: "memory");
    float rli[16];
#pragma unroll
    for (int r = 0; r < 16; ++r) rli[r] = __builtin_amdgcn_rcpf(li_l[crow(r, hie)]);
    float* xch = (float*)(lds + LDS_XCH) + wq * (32 * 128);
    if (mw == 1) {
#pragma unroll
        for (int r = 0; r < 16; ++r) { const int orow = crow(r, hie);
#pragma unroll
            for (int d0 = 0; d0 < 4; ++d0) xch[orow * 128 + d0 * 32 + r32e] = o[d0][r] * rli[r]; }
    }
    __syncthreads();
    if (mw == 0) {
        bf16* Ow = cur.O + (size_t)(wq * QBLK) * OPITCH;
        float sub[4];
#pragma unroll
        for (int d0 = 0; d0 < 4; ++d0) sub[d0] = C.subln[d0 * 32 + r32e];
#pragma unroll
        for (int r = 0; r < 16; ++r) { const int orow = crow(r, hie); float a[4]; float ss = 0.f;
#pragma unroll
            for (int d0 = 0; d0 < 4; ++d0) { a[d0] = o[d0][r] * rli[r] - C.lam * xch[orow * 128 + d0 * 32 + r32e]; ss += a[d0] * a[d0]; }
#pragma unroll
            for (int ofs = 1; ofs < 32; ofs <<= 1) ss += __shfl_xor(ss, ofs);
            const float rs = __builtin_amdgcn_rsqf(ss * (1.0f / 128.0f) + EPS) * C.oscale;
#pragma unroll
            for (int d0 = 0; d0 < 4; ++d0) { const float v = a[d0] * rs * sub[d0]; const float vn = __shfl_xor(v, 1);
                if ((r32e & 1) == 0) *(unsigned*)(Ow + (size_t)orow * OPITCH + d0 * 32 + r32e) = cvtpk(v, vn); } }
    }
    __syncthreads();
#undef RESC
#undef KBASE
#undef MASKT
#undef SEAM_K0
#undef HALF_STEP
}
__device__ __forceinline__ BlockRef mkref(int L, int pass, const bf16* QA, const bf16* KA, const bf16* VA, bf16* MRG) {
    const int bh = L & 7, b = bh >> 2, h = bh & 3, y = L >> 3, qb = pass ? y : 63 - y;
    BlockRef r; r.P0 = qb * QB;
    r.Q = QA + ((size_t)b * SEQ + r.P0) * PITCH + h * 128; r.K = KA + (size_t)b * SEQ * PITCH + h * 128; r.V = VA + (size_t)b * SEQ * PITCH + h * 128;
    r.O = MRG + ((size_t)b * SEQ + r.P0) * OPITCH + 512 + h * 128;
    return r;
}
__device__ __forceinline__ void attn_phase(char* lds, const bf16* QA, const bf16* KA, const bf16* VA, bf16* MRG, const Consts& C, int G, int bx) {
    constexpr int total = 256;
    int L = bx; if (L >= total) return;
    int pass = 0;
    BlockRef cur = mkref(L, 0, QA, KA, VA, MRG);
    Seam S;
    prime(cur, lds, S);
    for (;;) {
        const bool more_pass = pass == 0, more_item = L + G < total, last = !more_pass && !more_item;
        int passn = pass + 1, Ln = L;
        if (!more_pass) { passn = 0; Ln = more_item ? L + G : L; }
        const BlockRef nxt = last ? cur : mkref(Ln, passn, QA, KA, VA, MRG);
        block(cur, nxt, lds, S, C);
        if (last) break;
        cur = nxt; pass = passn; L = Ln;
    }
}
#undef AROW
#undef VMW
#undef VMWN
#undef SLOAD_H
#undef SWRITE_HK
#undef SWRITE_HV
#undef SWRITE_H
#undef KSWZ
#undef SBAR
}
#define XB_TMO      128
#define XB_XCNT(j)  (256  + 64 * (j))
#define XB_XSUB(j)  (1280 + 64 * (j))
#define XB_XGEN(j)  (2304 + 64 * (j))
#define XB_TOP      3328
#define XB_TOPGEN   3392
#define XCD_BAR_WORDS 3456
#define XB_SPIN_CAP (1u << 18)

__device__ __forceinline__ unsigned xb_ld(unsigned* p)              { return __hip_atomic_load(p, __ATOMIC_RELAXED, __HIP_MEMORY_SCOPE_AGENT); }
__device__ __forceinline__ unsigned xb_add(unsigned* p, unsigned v) { return __hip_atomic_fetch_add(p, v, __ATOMIC_RELAXED, __HIP_MEMORY_SCOPE_AGENT); }
__device__ __forceinline__ unsigned xb_xcc_id() { return (unsigned)__builtin_amdgcn_s_getreg((3 << 11) | 20) & 0xFu; }
#define XB_SPIN(cond, bar) do { unsigned _sp = 0; while (cond) { __builtin_amdgcn_s_sleep(1); \
    if ((++_sp & 255u) == 0u) { if (xb_ld(&(bar)[XB_TMO])) break; if (_sp > XB_SPIN_CAP) { atomicAdd(&(bar)[XB_TMO], 1u); break; } } } } while (0)

struct XcdBarrier {
    unsigned* bar; unsigned x;
    volatile LAS unsigned* st;
};

__device__ __forceinline__ XcdBarrier xcd_barrier_post(unsigned* bar, volatile LAS unsigned* st) {
    XcdBarrier b; b.bar = bar; b.x = xb_xcc_id(); b.st = st;
    if (threadIdx.x == 0) (void)xb_add(&bar[XB_XCNT(b.x)], 1u);
    return b;
}
__device__ __forceinline__ void xcd_barrier_complete(unsigned* bar, unsigned x, unsigned& nloc, unsigned& nx) {
    const unsigned G = gridDim.x * gridDim.y * gridDim.z;
    unsigned sum, cnt, mine, sp = 0u;
    for (;;) {
        sum = 0u; cnt = 0u; mine = 0u;
#pragma unroll
        for (unsigned j = 0; j < 16; ++j) { const unsigned c = xb_ld(&bar[XB_XCNT(j)]); sum += c; cnt += (c > 0u) ? 1u : 0u; mine = (j == x) ? c : mine; }
        if (sum == G) break;
        __builtin_amdgcn_s_sleep(1);
        if ((++sp & 255u) == 0u) { if (xb_ld(&bar[XB_TMO])) break; if (sp > XB_SPIN_CAP) { atomicAdd(&bar[XB_TMO], 1u); break; } }
    }
    nloc = mine > 0u ? mine : 1u; nx = cnt > 0u ? cnt : 1u;
}

__device__ __forceinline__ void xcd_barrier(const XcdBarrier& b) {
    asm volatile("s_waitcnt vmcnt(0)" ::: "memory");
    __syncthreads();
    if (threadIdx.x == 0) {
        unsigned* bar = b.bar;
        __builtin_amdgcn_s_waitcnt(0);
        unsigned nloc = b.st[0], nx = b.st[1];
        if (nloc == 0u) { xcd_barrier_complete(bar, b.x, nloc, nx); b.st[0] = nloc; b.st[1] = nx; }
        const unsigned old = xb_add(&bar[XB_XSUB(b.x)], 1u);
        const unsigned gen = old / nloc;
        if (old + 1u == (gen + 1u) * nloc) {
            __builtin_amdgcn_fence(__ATOMIC_RELEASE, "agent");
            asm volatile("s_waitcnt vmcnt(0)" ::: "memory");
            const unsigned og = xb_add(&bar[XB_TOP], 1u);
            const unsigned tg = og / nx;
            if (og + 1u == (tg + 1u) * nx) xb_add(&bar[XB_TOPGEN], 1u);
            else XB_SPIN(xb_ld(&bar[XB_TOPGEN]) == tg, bar);
            __builtin_amdgcn_fence(__ATOMIC_ACQUIRE, "agent");
            xb_add(&bar[XB_XGEN(b.x)], 1u);
            asm volatile("s_waitcnt vmcnt(0)" ::: "memory");
        } else {
            XB_SPIN(xb_ld(&bar[XB_XGEN(b.x)]) == gen, bar);
            __builtin_amdgcn_fence(__ATOMIC_ACQUIRE, "agent");
            asm volatile("s_waitcnt vmcnt(0)" ::: "memory");
        }
    }
    __syncthreads();
}
constexpr int NWAVES = 8;
__device__ __forceinline__ f32x16 mfma32(bf16x8 a, bf16x8 b, f32x16 c) { return __builtin_amdgcn_mfma_f32_32x32x16_bf16(a, b, c, 0, 0, 0); }
__device__ __forceinline__ int crow32(int r, int hi) { return (r & 3) + 8 * (r >> 2) + 4 * hi; }
__device__ __forceinline__ f32x16 mm32(const unsigned char* A, int astr, const unsigned char* B, int bstr, int ksteps, int r, int hh) {
    f32x16 acc = {};
    for (int s = 0; s < ksteps; ++s) {
        const bf16x8 a = *(const bf16x8*)(A + r * astr + (16 * s + 8 * hh) * 2);
        const bf16x8 b = *(const bf16x8*)(B + r * bstr + (16 * s + 8 * hh) * 2);
        acc = mfma32(a, b, acc);
    }
    return acc;
}

template <int MODE>
__device__ __forceinline__ void p0_transpose_item(const float* W, int K, int N, bf16* WT, const float* kscale, float* scr, int item, int lane) {
    const int nblk = N / 32, kb = item / nblk, nb = item % nblk, k0 = 64 * kb, n0 = 32 * nb;
#pragma unroll 8
    for (int i = 0; i < 32; ++i) { const int kk = 2 * i + (lane >> 5); float w = W[(size_t)(k0 + kk) * N + n0 + (lane & 31)]; if (kscale) w *= kscale[k0 + kk]; scr[kk * 33 + (lane & 31)] = w; }
    LDS_WAIT(); asm volatile("" ::: "memory");
    const int c = lane & 7;
#pragma unroll
    for (int j = 0; j < 4; ++j) { const int n = (lane >> 3) + 8 * j; const float* s = scr + (8 * c) * 33 + n;
        v4u o; o.x = pk2(s[0 * 33], s[1 * 33]); o.y = pk2(s[2 * 33], s[3 * 33]); o.z = pk2(s[4 * 33], s[5 * 33]); o.w = pk2(s[6 * 33], s[7 * 33]);
        const int gn = n0 + n; const int drow = MODE == 0 ? gn : ((gn >> 2) * 8 + (gn & 3) + (MODE == 2 ? 4 : 0));
        *(v4u*)(WT + (size_t)drow * K + k0 + 8 * c) = o; }
    LDS_WAIT(); asm volatile("" ::: "memory");
}
__device__ __forceinline__ void rms_row_to_bf16(const float* xrow, const float* gain, bf16* orow, int lane) {
    const f32x4* xr = (const f32x4*)xrow + lane; const f32x4* gr = (const f32x4*)gain + lane;
    f32x4 v[4]; float s = 0.f;
#pragma unroll
    for (int j = 0; j < 4; ++j) { v[j] = xr[64 * j]; s += (v[j].x * v[j].x + v[j].y * v[j].y) + (v[j].z * v[j].z + v[j].w * v[j].w); }
    const float rstd = __builtin_amdgcn_rsqf(wave_sum(s) * (1.f / DM) + EPS);
    unsigned long long* o8 = (unsigned long long*)orow + lane;
#pragma unroll
    for (int j = 0; j < 4; ++j) { const f32x4 g = gr[64 * j]; o8[64 * j] = (unsigned long long)pk2(v[j].x * rstd * g.x, v[j].y * rstd * g.y) | ((unsigned long long)pk2(v[j].z * rstd * g.z, v[j].w * rstd * g.w) << 32); }
}
__device__ __forceinline__ void rms_row_inplace(float* xrow, const float* gain, int lane) {
    f32x4* xr = (f32x4*)xrow + lane; const f32x4* gr = (const f32x4*)gain + lane;
    f32x4 v[4]; float s = 0.f;
#pragma unroll
    for (int j = 0; j < 4; ++j) { v[j] = xr[64 * j]; s += (v[j].x * v[j].x + v[j].y * v[j].y) + (v[j].z * v[j].z + v[j].w * v[j].w); }
    const float rstd = __builtin_amdgcn_rsqf(wave_sum(s) * (1.f / DM) + EPS);
#pragma unroll
    for (int j = 0; j < 4; ++j) { const f32x4 g = gr[64 * j]; xr[64 * j] = v[j] * rstd * g; }
}

template <int KDIM>
__device__ __forceinline__ f32x4 mini_tile(const bf16* A, const bf16* Brow, int wave, int lane) {
    const bf16* ap = A + (size_t)(16 * wave + (lane & 15)) * KDIM + 8 * (lane >> 4);
    const bf16* bp = Brow + 8 * (lane >> 4);
    f32x4 acc = {0.f, 0.f, 0.f, 0.f};
#pragma unroll 8
    for (int k0 = 0; k0 < KDIM; k0 += 32) {
        const bf16x8 a = *(const bf16x8*)(ap + k0), b = *(const bf16x8*)(bp + k0);
        acc = __builtin_amdgcn_mfma_f32_16x16x32_bf16(a, b, acc, 0, 0, 0);
    }
    return acc;
}

namespace hg {
constexpr int QT_OFF = 0, KT_OFF = 64 * 272, KTT_OFF = KT_OFF + 64 * 272, VT_OFF = KTT_OFF + 128 * 144, AM_OFF = VT_OFF + 128 * 144, SEG_OFF = AM_OFF + 64 * 144, SCL_OFF = SEG_OFF + 2048;
__device__ __forceinline__ void h1_unit(unsigned char* lds, int u, const bf16* QS, const float* G, const bf16* VR, bf16* QBg, float* KVT, float* DEC, float* OI, int tid, int wave, int lane) {
    const int bh = u >> 7, c = u & 127, b = bh >> 2, h = bh & 3, row0 = b * SEQ + c * CH, colb = h * 128;
    const int col = tid & 127, seg = tid >> 7;
    unsigned char* QT = lds + QT_OFF; unsigned char* KT = lds + KT_OFF; unsigned char* KTT = lds + KTT_OFF; unsigned char* VT = lds + VT_OFF; unsigned char* AM = lds + AM_OFF;
    float* SEG = (float*)(lds + SEG_OFF); float* SCL = (float*)(lds + SCL_OFF);
    float cs[16]; unsigned short qs[16], vv[16];
    { const size_t base = (size_t)(row0 + seg * 16) * 512 + colb + col;
#pragma unroll
      for (int j = 0; j < 16; ++j) { cs[j] = G[base + (size_t)j * 512]; qs[j] = QS[base + (size_t)j * 512]; vv[j] = VR[base + (size_t)j * 512]; } }
    float gk[16];
#pragma unroll
    for (int j = 0; j < 16; ++j) gk[j] = 1.0f - fexp(cs[j]);
#pragma unroll
    for (int j = 1; j < 16; ++j) cs[j] += cs[j - 1];
    SEG[seg * 128 + col] = cs[15];
    __syncthreads();
    const float t0 = SEG[col], t1 = SEG[128 + col], t2 = SEG[256 + col], t3 = SEG[384 + col];
    const float pre = (seg > 0 ? t0 : 0.f) + (seg > 1 ? t1 : 0.f) + (seg > 2 ? t2 : 0.f);
    const float bref = t0 + t1, blast = (t0 + t1) + (t2 + t3);
    if (seg == 0) { DEC[(size_t)u * 128 + col] = fexp(blast); SCL[col] = fexp(blast - bref); }
    unsigned ktp[8], vtp[8];
#pragma unroll
    for (int j = 0; j < 16; j += 2) {
        float kt2[2];
#pragma unroll
        for (int e = 0; e < 2; ++e) { const int jj = j + e; const float bb = cs[jj] + pre, qv = bf2f(qs[jj]);
            const float qt = qv * fexp(bb - bref), kt = gk[jj] * fexp(bref - bb), qb = qv * fexp(bb);
            const int row = seg * 16 + jj;
            *(unsigned short*)(QT + row * 272 + col * 2) = (unsigned short)f2bf(qt);
            *(unsigned short*)(KT + row * 272 + col * 2) = (unsigned short)f2bf(kt);
            QBg[(size_t)(row0 + row) * 512 + colb + col] = (unsigned short)f2bf(qb);
            kt2[e] = kt; }
        ktp[j >> 1] = pk2(kt2[0], kt2[1]); vtp[j >> 1] = (unsigned)vv[j] | ((unsigned)vv[j + 1] << 16);
    }
    *(v4u*)(KTT + col * 144 + seg * 32) = (v4u){ktp[0], ktp[1], ktp[2], ktp[3]}; *(v4u*)(KTT + col * 144 + seg * 32 + 16) = (v4u){ktp[4], ktp[5], ktp[6], ktp[7]};
    *(v4u*)(VT + col * 144 + seg * 32) = (v4u){vtp[0], vtp[1], vtp[2], vtp[3]}; *(v4u*)(VT + col * 144 + seg * 32 + 16) = (v4u){vtp[4], vtp[5], vtp[6], vtp[7]};
    __syncthreads();
    const int r = lane & 31, hh = lane >> 5;
#pragma unroll
    for (int tt = 0; tt < 2; ++tt) { const int vi = wave >> 1, ki = (wave & 1) * 2 + tt;
        const f32x16 acc = mm32(VT + vi * 32 * 144, 144, KTT + ki * 32 * 144, 144, 4, r, hh);
        const int k = ki * 32 + r; const float sc = SCL[k];
#pragma unroll
        for (int i = 0; i < 16; ++i) { const int v = vi * 32 + crow32(i, hh); KVT[((size_t)u * 128 + v) * 128 + k] = acc[i] * sc; } }
    if (wave < 4) { const int ti = wave >> 1, si = wave & 1;
        const f32x16 acc = mm32(QT + ti * 32 * 272, 272, KT + si * 32 * 272, 272, 8, r, hh);
        const int s = si * 32 + r;
#pragma unroll
        for (int i = 0; i < 16; ++i) { const int t = ti * 32 + crow32(i, hh); *(unsigned short*)(AM + t * 144 + s * 2) = (unsigned short)f2bf(s <= t ? acc[i] : 0.f); } }
    __syncthreads();
    { const int ti = wave >> 2, vi = wave & 3;
        const f32x16 acc = mm32(AM + ti * 32 * 144, 144, VT + vi * 32 * 144, 144, 4, r, hh);
        const int v = vi * 32 + r;
#pragma unroll
        for (int i = 0; i < 16; ++i) { const int t = ti * 32 + crow32(i, hh); OI[(size_t)(row0 + t) * 512 + colb + v] = acc[i]; } }
    __syncthreads();
}
__device__ __forceinline__ void h2_scan(int idx, const float* KVT, const float* DEC, bf16* ST, float* sout) {
    const int bh = idx >> 14, vk = idx & 16383, k = idx & 127, v = (idx >> 7) & 127;
    const float* kv = KVT + (size_t)bh * 128 * 16384 + vk; const float* dc = DEC + (size_t)bh * 128 * 128 + k; bf16* st = ST + (size_t)bh * 128 * 16384 + vk;
    float s = 0.f;
    for (int c0 = 0; c0 < NCH; c0 += 8) {
        float a[8], d[8];
#pragma unroll
        for (int j = 0; j < 8; ++j) { a[j] = kv[(size_t)(c0 + j) * 16384]; d[j] = dc[(c0 + j) * 128]; }
#pragma unroll
        for (int j = 0; j < 8; ++j) { st[(size_t)(c0 + j) * 16384] = (unsigned short)f2bf(s); s = d[j] * s + a[j]; }
    }
    sout[((size_t)bh * 128 + k) * 128 + v] = s;
}
constexpr int QBL_OFF = 0, STL_OFF = 64 * 272, RS_OFF = STL_OFF + 128 * 272;
__device__ __forceinline__ void h3_unit(unsigned char* lds, int u, const bf16* QBg, const bf16* ST, const float* OI, const bf16* GS, const float* rgn, bf16* MRG, int tid, int wave, int lane) {
    const int bh = u >> 7, c = u & 127, b = bh >> 2, h = bh & 3, row0 = b * SEQ + c * CH, colb = h * 128;
    unsigned char* QBL = lds + QBL_OFF; unsigned char* STL = lds + STL_OFF; float* RS = (float*)(lds + RS_OFF);
#pragma unroll
    for (int i = 0; i < 2; ++i) { const int q = tid + 512 * i, row = q >> 4, c16 = q & 15;
        *(v4u*)(QBL + row * 272 + c16 * 16) = *(const v4u*)(QBg + (size_t)(row0 + row) * 512 + colb + c16 * 8); }
#pragma unroll
    for (int i = 0; i < 4; ++i) { const int q = tid + 512 * i, v = q >> 4, c16 = q & 15;
        *(v4u*)(STL + v * 272 + c16 * 16) = *(const v4u*)(ST + ((size_t)u * 128 + v) * 128 + c16 * 8); }
    __syncthreads();
    const int r = lane & 31, hh = lane >> 5, ti = wave >> 2, vi = wave & 3, v = vi * 32 + r;
    const f32x16 acc = mm32(QBL + ti * 32 * 272, 272, STL + vi * 32 * 272, 272, 8, r, hh);
    float o[16];
#pragma unroll
    for (int i = 0; i < 16; ++i) { const int t = ti * 32 + crow32(i, hh); o[i] = acc[i] + OI[(size_t)(row0 + t) * 512 + colb + v];
        float ss = o[i] * o[i];
#pragma unroll
        for (int ofs = 1; ofs < 32; ofs <<= 1) ss += __shfl_xor(ss, ofs);
        if (r == 0) RS[t * 4 + vi] = ss; }
    __syncthreads();
    const float gn = rgn[v];
#pragma unroll
    for (int i = 0; i < 16; ++i) { const int t = ti * 32 + crow32(i, hh);
        const f32x4 p = *(const f32x4*)(RS + t * 4); const float rstd = __builtin_amdgcn_rsqf(((p[0] + p[1]) + (p[2] + p[3])) * (1.0f / 128.0f) + EPS);
        const float gs = bf2f(GS[(size_t)(row0 + t) * 512 + colb + v]);
        MRG[(size_t)(row0 + t) * 1024 + colb + v] = (unsigned short)f2bf(o[i] * rstd * gn * gs); }
    __syncthreads();
}
}

namespace dec {
constexpr int WML_OFF = 0, WO_OFF = 1024, LDS_BYTES = WO_OFF + 8 * 2 * 512 * 4;
#ifndef DEC_NT
#define DEC_NT 0
#endif
__device__ __forceinline__ void partial_wave(int unit, const float* cache_k, const float* cache_v, const int* ptab, const float* PSs, float* PARTML, float* PARTO, int lane) {
    const int i = unit >> 4, page = ptab[unit];
    const float* Kp = cache_k + (size_t)page * 65536 + 8 * lane;
    const float* Vp = cache_v + (size_t)page * 65536 + 8 * lane;
    float q[8];
    { const f32x4 q0 = *(const f32x4*)(PSs + (size_t)i * DIN + 2048 + 8 * lane), q1 = *(const f32x4*)(PSs + (size_t)i * DIN + 2048 + 8 * lane + 4);
#pragma unroll
      for (int e = 0; e < 4; ++e) { q[e] = q0[e] * (0.125f * LOG2E); q[4 + e] = q1[e] * (0.125f * LOG2E); } }
#if DEC_NT
#define NTL(p) __builtin_nontemporal_load((const f32x4*)(p))
#else
#define NTL(p) (*(const f32x4*)(p))
#endif
#define DPPF(x, ctrl) __builtin_bit_cast(float, __builtin_amdgcn_update_dpp(0, __builtin_bit_cast(int, (x)), (ctrl), 0xf, 0xf, true))
    const bool hi8 = (lane & 8) != 0;
    float m0 = -1e30f, m1 = -1e30f, l0 = 0.f, l1 = 0.f, o0[8], o1[8];
#pragma unroll
    for (int e = 0; e < 8; ++e) { o0[e] = 0.f; o1[e] = 0.f; }
    f32x4 kA[4][2], vA[4][2], kB[4][2], vB[4][2];
#define LOADG(KX, VX, g) do { _Pragma("unroll") for (int kk = 0; kk < 4; ++kk) { const size_t ro = (size_t)((g) * 4 + kk) * 512; \
        KX[kk][0] = NTL(Kp + ro); KX[kk][1] = NTL(Kp + ro + 4); VX[kk][0] = NTL(Vp + ro); VX[kk][1] = NTL(Vp + ro + 4); } } while (0)
#define PROCG(KX, VX) do { float s0[4], s1[4]; \
        _Pragma("unroll") for (int kk = 0; kk < 4; ++kk) { \
            float d = (KX[kk][0][0] * q[0] + KX[kk][0][1] * q[1]) + (KX[kk][0][2] * q[2] + KX[kk][0][3] * q[3]) + (KX[kk][1][0] * q[4] + KX[kk][1][1] * q[5]) + (KX[kk][1][2] * q[6] + KX[kk][1][3] * q[7]); \
            d += DPPF(d, 0xB1); d += DPPF(d, 0x4E); d += DPPF(d, 0x141); const float e_ = DPPF(d, 0x128); s0[kk] = hi8 ? e_ : d; s1[kk] = hi8 ? d : e_; } \
        const float n0 = fmaxf(fmaxf(fmaxf(s0[0], s0[1]), fmaxf(s0[2], s0[3])), m0), n1 = fmaxf(fmaxf(fmaxf(s1[0], s1[1]), fmaxf(s1[2], s1[3])), m1); \
        const float a0 = __builtin_amdgcn_exp2f(m0 - n0), a1 = __builtin_amdgcn_exp2f(m1 - n1); m0 = n0; m1 = n1; \
        float ps0 = 0.f, ps1 = 0.f; \
        _Pragma("unroll") for (int kk = 0; kk < 4; ++kk) { s0[kk] = __builtin_amdgcn_exp2f(s0[kk] - n0); s1[kk] = __builtin_amdgcn_exp2f(s1[kk] - n1); ps0 += s0[kk]; ps1 += s1[kk]; } \
        l0 = l0 * a0 + ps0; l1 = l1 * a1 + ps1; \
        _Pragma("unroll") for (int e = 0; e < 4; ++e) { \
            o0[e] = o0[e] * a0 + ((s0[0] * VX[0][0][e] + s0[1] * VX[1][0][e]) + (s0[2] * VX[2][0][e] + s0[3] * VX[3][0][e])); \
            o0[4 + e] = o0[4 + e] * a0 + ((s0[0] * VX[0][1][e] + s0[1] * VX[1][1][e]) + (s0[2] * VX[2][1][e] + s0[3] * VX[3][1][e])); \
            o1[e] = o1[e] * a1 + ((s1[0] * VX[0][0][e] + s1[1] * VX[1][0][e]) + (s1[2] * VX[2][0][e] + s1[3] * VX[3][0][e])); \
            o1[4 + e] = o1[4 + e] * a1 + ((s1[0] * VX[0][1][e] + s1[1] * VX[1][1][e]) + (s1[2] * VX[2][1][e] + s1[3] * VX[3][1][e])); } } while (0)
    LOADG(kA, vA, 0);
    for (int g = 0; g < 32; g += 2) {
        LOADG(kB, vB, g + 1);
        PROCG(kA, vA);
        if (g + 2 < 32) LOADG(kA, vA, g + 2);
        PROCG(kB, vB);
    }
#undef LOADG
#undef PROCG
#undef NTL
#undef DPPF
    if ((lane & 7) == 0) { const int hm = lane >> 3; PARTML[((size_t)unit * 8 + hm) * 2] = hi8 ? m1 : m0; PARTML[((size_t)unit * 8 + hm) * 2 + 1] = hi8 ? l1 : l0; }
    { float* w0 = PARTO + ((size_t)unit * 2 + 0) * 512 + 8 * lane; float* w1 = PARTO + ((size_t)unit * 2 + 1) * 512 + 8 * lane;
      *(f32x4*)w0 = (f32x4){o0[0], o0[1], o0[2], o0[3]}; *(f32x4*)(w0 + 4) = (f32x4){o0[4], o0[5], o0[6], o0[7]};
      *(f32x4*)w1 = (f32x4){o1[0], o1[1], o1[2], o1[3]}; *(f32x4*)(w1 + 4) = (f32x4){o1[4], o1[5], o1[6], o1[7]}; }
}
__device__ __forceinline__ void combine_item(unsigned char* lds, int i, const float* PSs, const float* PARTML, const float* PARTO, const float* subln, float lam, bf16* MRGs, int tid, int wave, int lane) {
    float* CW = (float*)lds;
    float* SSQ = (float*)(lds + 1024);
    { const int hm = wave;
      const float qv = PSs[(size_t)i * DIN + 2048 + hm * 64 + lane] * (0.125f * LOG2E), kn = PSs[(size_t)i * DIN + 2560 + hm * 64 + lane];
      const float sn = wave_sum(qv * kn);
      float Mj = -1e30f, Lj = 0.f;
      if (lane < 16) { Mj = PARTML[(((size_t)i * 16 + lane) * 8 + hm) * 2]; Lj = PARTML[(((size_t)i * 16 + lane) * 8 + hm) * 2 + 1]; }
      const float M = fmaxf(wave_max(Mj), sn);
      const float wj = (lane < 16) ? __builtin_amdgcn_exp2f(Mj - M) : 0.f, wn = __builtin_amdgcn_exp2f(sn - M);
      const float Lt = wave_sum(wj * Lj) + wn, inv = 1.0f / Lt;
      if (lane < 16) CW[hm * 17 + lane] = wj * inv;
      if (lane == 16) CW[hm * 17 + 16] = wn * inv; }
    __syncthreads();
    const int h = tid >> 7;
    float om[2];
#pragma unroll
    for (int m = 0; m < 2; ++m) { const int hm = 2 * h + m; float a = CW[hm * 17 + 16] * PSs[(size_t)i * DIN + 3072 + tid];
#pragma unroll
        for (int j = 0; j < 16; ++j) a += CW[hm * 17 + j] * PARTO[(((size_t)i * 16 + j) * 2 + m) * 512 + tid];
        om[m] = a; }
    const float a = om[0] - lam * om[1];
    const float ssw = wave_sum(a * a);
    if (lane == 0) SSQ[wave] = ssw;
    __syncthreads();
    const float ss = SSQ[2 * h] + SSQ[2 * h + 1];
    const float rstd = __builtin_amdgcn_rsqf(ss * (1.0f / 128.0f) + EPS);
    MRGs[(size_t)i * 1024 + 512 + tid] = (unsigned short)f2bf(a * rstd * subln[tid & 127] * (1.0f - LAM_INIT));
    __syncthreads();
}
__device__ __forceinline__ void recurrent_unit(unsigned char* lds, int unit, const float* PSs, const float* state, const float* lbp, const float* rgn, float* sout, bf16* MRGs, int tid, int wave, int lane) {
    const int i = unit >> 2, h = unit & 3;
    float* RO = (float*)lds;
    float* SSQ = (float*)(lds + 8192);
    const int v4 = (tid & 31) * 4, ks = tid >> 5;
    const float* ps = PSs + (size_t)i * DIN;
    const f32x4 vv = *(const f32x4*)(ps + 1024 + h * 128 + v4);
    const float* sp = state + ((size_t)unit * 128) * 128 + v4; float* so = sout + ((size_t)unit * 128) * 128 + v4;
    f32x4 po = {0.f, 0.f, 0.f, 0.f};
    f32x4 sold[8];
#pragma unroll
    for (int jj = 0; jj < 8; ++jj) sold[jj] = *(const f32x4*)(sp + (size_t)(ks + 16 * jj) * 128);
#pragma unroll
    for (int jj = 0; jj < 8; ++jj) { const int k = ks + 16 * jj, kc = h * 128 + k;
        const float lb = sigm(lbp[kc] - lbp[512 + kc]); const float f = lb + (1.0f - lb) * sigm(ps[512 + kc]); const float kk = 1.0f - f, qk = siluf(ps[kc]);
        const f32x4 sn = sold[jj] * f + vv * kk; *(f32x4*)(so + (size_t)k * 128) = sn; po += sn * qk; }
    *(f32x4*)(RO + ks * 128 + v4) = po;
    __syncthreads();
    float o = 0.f;
    if (tid < 128) {
#pragma unroll
        for (int j = 0; j < 16; ++j) o += RO[j * 128 + tid];
        const float ssw = wave_sum(o * o); if (lane == 0) SSQ[wave] = ssw; }
    __syncthreads();
    if (tid < 128) { const float rstd = __builtin_amdgcn_rsqf((SSQ[0] + SSQ[1]) * (1.0f / 128.0f) + EPS);
        MRGs[(size_t)i * 1024 + h * 128 + tid] = (unsigned short)f2bf(o * rstd * rgn[tid] * siluf(ps[1536 + h * 128 + tid])); }
    __syncthreads();
}
}
#ifndef MK_N_LAUNCHES
#define MK_N_LAUNCHES 1
#endif
constexpr int N_PHASES = 9;
constexpr int N_LAUNCHES = MK_N_LAUNCHES;
static_assert(N_LAUNCHES == 1 || N_LAUNCHES == N_PHASES, "MK_N_LAUNCHES is 1 or 9");
constexpr size_t MiB = 1u << 20;
constexpr size_t WS_CTL = 0, CTL_ZERO_BYTES = 1 * MiB;
constexpr size_t WS_WIN = 2 * MiB;
constexpr size_t WS_WOUT = 10 * MiB;
constexpr size_t WS_WGU = 12 * MiB;
constexpr size_t WS_WD = 24 * MiB;
constexpr size_t WS_PSS = 30 * MiB;
constexpr size_t WS_PS1 = 32 * MiB;
constexpr size_t WS_PS1S = 33 * MiB;
constexpr size_t WS_DEC = 34 * MiB;
constexpr size_t WS_PML = 35 * MiB;
constexpr size_t WS_PO = 36 * MiB;
constexpr size_t WS_XN = 48 * MiB;
constexpr size_t WS_QS = 96 * MiB, WS_VR = 112 * MiB, WS_GS = 128 * MiB, WS_QA = 144 * MiB, WS_KA = 160 * MiB, WS_VA = 176 * MiB;
constexpr size_t WS_G = 192 * MiB;
constexpr size_t WS_QB = 224 * MiB;
constexpr size_t WS_OI = 240 * MiB;
constexpr size_t WS_KVT = 272 * MiB;
constexpr size_t WS_ST = 336 * MiB;
constexpr size_t WS_MRG = 368 * MiB;
constexpr size_t WS_X1 = 416 * MiB;
constexpr size_t WS_XB = 496 * MiB;
constexpr size_t WS_H = 544 * MiB;
constexpr size_t WS_END = 640 * MiB;
constexpr int CW_TMO = 0, CW_BAR = 4096;
constexpr size_t O_Y = 0, O_YS = (size_t)MP * DM, O_KP = O_YS + (size_t)MS * DM, O_VP = O_KP + (size_t)MP * 512, O_SP = O_VP + (size_t)MP * 512,
                 O_KS = O_SP + 8 * 16384, O_VS = O_KS + (size_t)MS * 512, O_SS = O_VS + (size_t)MS * 512, O_END = O_SS + (size_t)MS * 4 * 16384;
constexpr int RING_OFF = 0, RING_BYTES = 143360;
constexpr int LDSCTL_OFF = RING_BYTES, MISC_OFF = LDSCTL_OFF + 320;
constexpr int LDS_BYTES = 147456;
static_assert(att::LDS_BYTES <= RING_BYTES && MISC_OFF + 128 <= LDS_BYTES, "LDS map");

struct Args { const float* in[21]; const int* ptab; float* out; unsigned char* ws; int ph_lo, ph_hi; };

__global__ void __launch_bounds__(NWAVES * 64, 2) mk_fwd(Args args) {
    extern __shared__ __attribute__((aligned(16))) unsigned char lds[];
    const int tid = threadIdx.x, lane = tid & 63, wave = __builtin_amdgcn_readfirstlane(tid >> 6);
    const int G = gridDim.x, bx = blockIdx.x;
    volatile LAS unsigned* MISC = (volatile LAS unsigned*)((LAS unsigned char*)lds + MISC_OFF);
    unsigned char* ws = args.ws;
    gu32* ctl = (gu32*)(ws + WS_CTL);
    for (int u = tid; u < (LDS_BYTES - LDSCTL_OFF) / 4; u += NWAVES * 64) ((LAS unsigned*)((LAS unsigned char*)lds + LDSCTL_OFF))[u] = 0u;
    __syncthreads();
    XcdBarrier bar; bar.bar = (unsigned*)(ctl + CW_BAR); bar.x = 0; bar.st = nullptr;
    if (N_LAUNCHES == 1) bar = xcd_barrier_post((unsigned*)(ctl + CW_BAR), MISC + 8);
#ifndef BAR_REPS
#define BAR_REPS 1
#endif
#define GRID_BAR() do { if (N_LAUNCHES == 1) { for (int br_ = 0; br_ < BAR_REPS; ++br_) xcd_barrier(bar); } } while (0)
    const int lo = args.ph_lo, hi = args.ph_hi;
#ifndef PHASE_MASK
#define PHASE_MASK 0x1ff
#endif
#define IN(k) (((PHASE_MASK >> (k)) & 1) && lo <= (k) && (k) < hi)
#define BOTH(k) (IN(k) && IN((k) + 1))
#ifndef DBL_MASK
#define DBL_MASK 0
#endif
#define NREP(k) (((DBL_MASK >> (k)) & 1) ? 2 : 1)
    const float* x_p = args.in[0]; const float* x_s = args.in[1]; const float* cache_k = args.in[2]; const float* cache_v = args.in[3]; const float* state = args.in[4];
    const float* w_in = args.in[6]; const float* w_out = args.in[7]; const float* lbp = args.in[8]; const float* rgn = args.in[9];
    const float* lq1 = args.in[10]; const float* lk1 = args.in[11]; const float* lq2 = args.in[12]; const float* lk2 = args.in[13]; const float* subln = args.in[14];
    const float* n_mix = args.in[15]; const float* n_ffn = args.in[16]; const float* w_gate = args.in[17]; const float* w_up = args.in[18]; const float* w_down = args.in[19]; const float* n_fin = args.in[20];
    const int* ptab = args.ptab; float* out = args.out;
    bf16* Win_t = (bf16*)(ws + WS_WIN); bf16* Wout_t = (bf16*)(ws + WS_WOUT); bf16* Wgu_t = (bf16*)(ws + WS_WGU); bf16* Wd_t = (bf16*)(ws + WS_WD);
    float* PSs = (float*)(ws + WS_PSS); float* PS1 = (float*)(ws + WS_PS1); float* PS1s = (float*)(ws + WS_PS1S); float* DEC = (float*)(ws + WS_DEC);
    float* PML = (float*)(ws + WS_PML); float* PO = (float*)(ws + WS_PO);
    bf16* XN = (bf16*)(ws + WS_XN); bf16* QS = (bf16*)(ws + WS_QS); bf16* VR = (bf16*)(ws + WS_VR); bf16* GS = (bf16*)(ws + WS_GS);
    bf16* QA = (bf16*)(ws + WS_QA); bf16* KA = (bf16*)(ws + WS_KA); bf16* VA = (bf16*)(ws + WS_VA); float* Gl = (float*)(ws + WS_G);
    bf16* QBg = (bf16*)(ws + WS_QB); float* OI = (float*)(ws + WS_OI); float* KVT = (float*)(ws + WS_KVT); bf16* ST = (bf16*)(ws + WS_ST);
    bf16* MRG = (bf16*)(ws + WS_MRG); float* X1 = (float*)(ws + WS_X1); bf16* XB = (bf16*)(ws + WS_XB); bf16* Hb = (bf16*)(ws + WS_H);

    if (IN(0)) { _Pragma("unroll") for (int rep = 0; rep < NREP(0); ++rep) {
        float* scr = (float*)(lds + RING_OFF + wave * 16384);
        const int gw = bx * NWAVES + wave, NGW = G * NWAVES;
        constexpr int I_IN = (DM / 64) * (DIN / 32), I_OUT = (DM / 64) * (DM / 32), I_G = (DM / 64) * (DFF / 32), I_D = (DFF / 64) * (DM / 32);
        constexpr int NITEMS = I_IN + I_OUT + 2 * I_G + I_D;
        for (int it = gw; it < NITEMS; it += NGW) {
            int r = it;
            if (r < I_IN) { p0_transpose_item<0>(w_in, DM, DIN, Win_t, nullptr, scr, r, lane); continue; } r -= I_IN;
            if (r < I_OUT) { p0_transpose_item<0>(w_out, DM, DM, Wout_t, nullptr, scr, r, lane); continue; } r -= I_OUT;
            if (r < I_G) { p0_transpose_item<1>(w_gate, DM, DFF, Wgu_t, n_ffn, scr, r, lane); continue; } r -= I_G;
            if (r < I_G) { p0_transpose_item<2>(w_up, DM, DFF, Wgu_t, n_ffn, scr, r, lane); continue; } r -= I_G;
            p0_transpose_item<0>(w_down, DFF, DM, Wd_t, nullptr, scr, r, lane);
        }
        for (int m = gw; m < MT; m += NGW) rms_row_to_bf16(m < MP ? x_p + (size_t)m * DM : x_s + (size_t)(m - MP) * DM, n_mix, XN + (size_t)m * DM, lane);
        __syncthreads(); }
        if (BOTH(0)) GRID_BAR();
    }
    if (IN(1)) { _Pragma("unroll") for (int rep = 0; rep < NREP(1); ++rep) {
        { pg8::Gemm g{XN, Win_t, MP, DIN, DM}; pg8::StaticOrder S; S.init(MP, DIN, G, bx);
          pg8::EpiInProj E{QS, VR, GS, QA, KA, VA, Gl, out + O_KP, out + O_VP, lbp};
          pg8::gemm_phase<pg8::EpiInProj, pg8::StaticOrder, true, true>((LAS unsigned char*)lds + RING_OFF, g, S, E); }
        if (bx >= G / 2) {
            for (int t = bx - G / 2; t < DIN / 16; t += G / 2) { const int n0 = t * 16;
                const f32x4 acc = mini_tile<DM>(XN + (size_t)MP * DM, Win_t + (size_t)(n0 + (lane & 15)) * DM, wave, lane);
                const int c = lane & 15, q = lane >> 4;
#pragma unroll
                for (int i = 0; i < 4; ++i) { const int row = 16 * wave + 4 * q + i; const float v = acc[i];
                    PSs[(size_t)row * DIN + n0 + c] = v;
                    if (n0 >= 2560 && n0 < 3072) out[O_KS + (size_t)row * 512 + (n0 - 2560) + c] = v;
                    if (n0 >= 3072) out[O_VS + (size_t)row * 512 + (n0 - 3072) + c] = v; } }
        } }
        if (BOTH(1)) GRID_BAR();
    }
    if (IN(2)) {
        for (int rep = 0; rep < NREP(9); ++rep) for (int u = bx; u < NHU; u += G) hg::h1_unit(lds + RING_OFF, u, QS, Gl, VR, QBg, KVT, DEC, OI, tid, wave, lane);
        __syncthreads();
        { att::Consts C; const float s1 = wave_sum(lq1[lane] * lk1[lane]), s2 = wave_sum(lq2[lane] * lk2[lane]);
          C.lam = __builtin_bit_cast(float, __builtin_amdgcn_readfirstlane(__builtin_bit_cast(int, fexp(s1) - fexp(s2) + LAM_INIT))); C.oscale = 1.0f - LAM_INIT; C.subln = subln;
          if ((bx & 7) < 4) { for (int rep = 0; rep < NREP(11); ++rep) for (int u = bx * NWAVES + wave; u < MS * NPAGES; u += G * NWAVES) dec::partial_wave(u, cache_k, cache_v, ptab, PSs, PML, PO, lane); }
          att::attn_phase((char*)lds + RING_OFF, QA, KA, VA, MRG, C, G, bx);
          if ((bx & 7) >= 4) { for (int rep = 0; rep < NREP(11); ++rep) for (int u = bx * NWAVES + wave; u < MS * NPAGES; u += G * NWAVES) dec::partial_wave(u, cache_k, cache_v, ptab, PSs, PML, PO, lane); } }
        if (BOTH(2)) GRID_BAR();
    }
    if (IN(3)) { _Pragma("unroll") for (int rep = 0; rep < NREP(3); ++rep) {
        for (int idx = bx * 512 + tid; idx < 8 * 16384; idx += G * 512) hg::h2_scan(idx, KVT, DEC, ST, out + O_SP);
        { const float s1 = wave_sum(lq1[lane] * lk1[lane]), s2 = wave_sum(lq2[lane] * lk2[lane]); const float lam = fexp(s1) - fexp(s2) + LAM_INIT;
          for (int i = bx; i < MS; i += G) dec::combine_item(lds + RING_OFF, i, PSs, PML, PO, subln, lam, MRG + (size_t)MP * DM, tid, wave, lane); }
        for (int u = bx; u < MS * 4; u += G) dec::recurrent_unit(lds + RING_OFF, u, PSs, state, lbp, rgn, out + O_SS, MRG + (size_t)MP * DM, tid, wave, lane); }
        if (BOTH(3)) GRID_BAR();
    }
    if (IN(4)) {
        for (int rep = 0; rep < NREP(4); ++rep) for (int u = bx; u < NHU; u += G) hg::h3_unit(lds + RING_OFF, u, QBg, ST, OI, GS, rgn, MRG, tid, wave, lane);
        if (BOTH(4)) GRID_BAR();
    }
    if (IN(5)) { _Pragma("unroll") for (int rep = 0; rep < NREP(5); ++rep) {
        { pg8::Gemm g{MRG, Wout_t, MP, DM, DM}; pg8::StaticOrder S; S.init(MP, DM, G, bx);
          pg8::EpiWout E{x_p, X1, XB, PS1};
          pg8::gemm_phase<pg8::EpiWout, pg8::StaticOrder, true, true>((LAS unsigned char*)lds + RING_OFF, g, S, E); }
        for (int t = bx; t < DM / 16; t += G) { const int n0 = t * 16;
            const f32x4 acc = mini_tile<DM>(MRG + (size_t)MP * DM, Wout_t + (size_t)(n0 + (lane & 15)) * DM, wave, lane);
            const int c = lane & 15, q = lane >> 4;
#pragma unroll
            for (int i = 0; i < 4; ++i) { const int row = 16 * wave + 4 * q + i; const float v = x_s[(size_t)row * DM + n0 + c] + acc[i];
                X1[(size_t)(MP + row) * DM + n0 + c] = v; XB[(size_t)(MP + row) * DM + n0 + c] = (unsigned short)f2bf(v);
                float ss = v * v; ss += __shfl_xor(ss, 1); ss += __shfl_xor(ss, 2); ss += __shfl_xor(ss, 4); ss += __shfl_xor(ss, 8);
                if (c == 0) PS1s[row * 64 + t] = ss; } } }
        if (BOTH(5)) GRID_BAR();
    }
    if (IN(6)) { _Pragma("unroll") for (int rep = 0; rep < NREP(6); ++rep) {
        { pg8::Gemm g{XB, Wgu_t, MP, NGU, DM}; pg8::StaticOrder S; S.init(MP, NGU, G, bx);
          pg8::EpiGateUp E{PS1, Hb};
          pg8::gemm_phase<pg8::EpiGateUp, pg8::StaticOrder, true, true>((LAS unsigned char*)lds + RING_OFF, g, S, E); }
        if (bx >= G / 2) {
            float* RSTD = (float*)(lds + RING_OFF);
            if (tid < MS) { float s = 0.f;
#pragma unroll
                for (int j = 0; j < 16; ++j) { const f32x4 p = *(const f32x4*)(PS1s + tid * 64 + 4 * j); s += (p[0] + p[1]) + (p[2] + p[3]); }
                RSTD[tid] = __builtin_amdgcn_rsqf(s * (1.0f / 1024.0f) + EPS); }
            __syncthreads();
            for (int t = bx - G / 2; t < DFF / 16; t += G / 2) { const int f0 = t * 16, f = f0 + (lane & 15), grow = (f >> 2) * 8 + (f & 3);
                const f32x4 ag = mini_tile<DM>(XB + (size_t)MP * DM, Wgu_t + (size_t)grow * DM, wave, lane);
                const f32x4 au = mini_tile<DM>(XB + (size_t)MP * DM, Wgu_t + (size_t)(grow + 4) * DM, wave, lane);
                const int c = lane & 15, q = lane >> 4;
#pragma unroll
                for (int i = 0; i < 4; ++i) { const int row = 16 * wave + 4 * q + i; const float rs = RSTD[row];
                    Hb[(size_t)(MP + row) * DFF + f0 + c] = (unsigned short)f2bf(siluf(ag[i] * rs) * (au[i] * rs)); } }
            __syncthreads();
        } }
        if (BOTH(6)) GRID_BAR();
    }
    if (IN(7)) { _Pragma("unroll") for (int rep = 0; rep < NREP(7); ++rep) {
        { pg8::Gemm g{Hb, Wd_t, MP, DM, DFF}; pg8::StaticOrder S; S.init(MP, DM, G, bx);
          pg8::EpiDown E{X1, out + O_Y};
          pg8::gemm_phase<pg8::EpiDown, pg8::StaticOrder, true, true>((LAS unsigned char*)lds + RING_OFF, g, S, E); }
        for (int t = bx; t < DM / 16; t += G) { const int n0 = t * 16;
            const f32x4 acc = mini_tile<DFF>(Hb + (size_t)MP * DFF, Wd_t + (size_t)(n0 + (lane & 15)) * DFF, wave, lane);
            const int c = lane & 15, q = lane >> 4;
#pragma unroll
            for (int i = 0; i < 4; ++i) { const int row = 16 * wave + 4 * q + i;
                out[O_YS + (size_t)row * DM + n0 + c] = X1[(size_t)(MP + row) * DM + n0 + c] + acc[i]; } } }
        if (BOTH(7)) GRID_BAR();
    }
    if (IN(8)) {
        const int gw = bx * NWAVES + wave, NGW = G * NWAVES;
        for (int m = gw; m < MT; m += NGW) rms_row_inplace(m < MP ? out + O_Y + (size_t)m * DM : out + O_YS + (size_t)(m - MP) * DM, n_fin, lane);
    }
#undef IN
#undef BOTH
#undef GRID_BAR
}

extern "C" void kernel_launch(void* const* d_in, const int* in_sizes, int n_in, void* d_out, int out_size, void* d_ws, size_t ws_size, hipStream_t stream) {
    static int grid = 0;
    if (grid == 0) {
        if (n_in != 21 || in_sizes[0] != MP * DM || (size_t)out_size != O_END || ws_size < WS_END) {
            fprintf(stderr, "kernel_launch: unexpected shapes (n_in %d, in0 %d, out %d, ws %zu); nothing launched\n", n_in, n_in > 0 ? in_sizes[0] : -1, out_size, ws_size); grid = -1; return; }
        int dev = 0, cus = 0, per_cu = 0;
        if (hipGetDevice(&dev) != hipSuccess || hipDeviceGetAttribute(&cus, hipDeviceAttributeMultiprocessorCount, dev) != hipSuccess) { grid = -1; return; }
        if (hipFuncSetAttribute((const void*)mk_fwd, hipFuncAttributeMaxDynamicSharedMemorySize, LDS_BYTES) != hipSuccess) { fprintf(stderr, "kernel_launch: hipFuncSetAttribute failed\n"); grid = -1; return; }
        if (hipOccupancyMaxActiveBlocksPerMultiprocessor(&per_cu, (const void*)mk_fwd, NWAVES * 64, LDS_BYTES) != hipSuccess || per_cu < 1)
            fprintf(stderr, "kernel_launch: note: occupancy query reports %d workgroups per CU\n", per_cu);
        (void)hipGetLastError();
        grid = cus;
        if (grid > 256) grid = 256;
        grid &= ~7;
    }
    if (grid <= 0) return;
    (void)hipMemsetAsync((char*)d_ws + WS_CTL, 0, CTL_ZERO_BYTES, stream);
    Args a{};
    for (int i = 0; i < 21; ++i) a.in[i] = (const float*)d_in[i];
    a.ptab = (const int*)d_in[5]; a.out = (float*)d_out; a.ws = (unsigned char*)d_ws;
    if (N_LAUNCHES == 1) { a.ph_lo = 0; a.ph_hi = N_PHASES; hipLaunchKernelGGL(mk_fwd, dim3(grid), dim3(NWAVES * 64), LDS_BYTES, stream, a); }
    else for (int p = 0; p < N_PHASES; ++p) { a.ph_lo = p; a.ph_hi = p + 1; hipLaunchKernelGGL(mk_fwd, dim3(grid), dim3(NWAVES * 64), LDS_BYTES, stream, a); }
    const hipError_t le = hipPeekAtLastError();
    if (le != hipSuccess) fprintf(stderr, "kernel_launch: launch failed: %s\n", hipGetErrorName(le));
}
```

```cpp
#include <hip/hip_runtime.h>
#include <hip/hip_bf16.h>
#include <cstdio>
#include <cstdint>

constexpr int DM = 1024, NBATCH = 2, SEQ = 8192, MP = NBATCH * SEQ, MS = 128, MT = MP + MS;
constexpr int DIN = 3584, DFF = 2816, NGU = 2 * DFF;
constexpr int NPAGES = 16, PAGE = 128;
constexpr int CH = 64, NCH = SEQ / CH, NHU = NBATCH * 4 * NCH;
constexpr float EPS = 1e-6f;
constexpr float LOG2E = 1.4426950408889634f, LN2 = 0.6931471805599453f;
constexpr float LAM_INIT = 0.2f;

#define GAS __attribute__((address_space(1)))
#define LAS __attribute__((address_space(3)))
typedef unsigned short bf16;
typedef unsigned v4u __attribute__((ext_vector_type(4)));
typedef unsigned v2u __attribute__((ext_vector_type(2)));
typedef float f32x4 __attribute__((ext_vector_type(4)));
typedef float f32x16 __attribute__((ext_vector_type(16)));
typedef short bf16x8 __attribute__((ext_vector_type(8)));
typedef GAS unsigned gu32;
#define RLX_AGENT __ATOMIC_RELAXED, __HIP_MEMORY_SCOPE_AGENT
#define LDS_WAIT() asm volatile("s_waitcnt lgkmcnt(0)" ::: "memory")
#define VM_WAIT() asm volatile("s_waitcnt vmcnt(0)" ::: "memory")
__device__ __forceinline__ unsigned f2bf(float f) { unsigned u = __builtin_bit_cast(unsigned, f); return (u + 0x7fffu + ((u >> 16) & 1u)) >> 16; }
__device__ __forceinline__ unsigned pk2(float lo, float hi) { return f2bf(lo) | (f2bf(hi) << 16); }
__device__ __forceinline__ float bf2f(unsigned short b) { return __builtin_bit_cast(float, (unsigned)b << 16); }
__device__ __forceinline__ float sigm(float x) { return __builtin_amdgcn_rcpf(1.0f + __builtin_amdgcn_exp2f(-LOG2E * x)); }
__device__ __forceinline__ float siluf(float x) { return x * sigm(x); }
__device__ __forceinline__ float fexp(float x) { return __builtin_amdgcn_exp2f(LOG2E * x); }
__device__ __forceinline__ float wave_sum(float v) {
#pragma unroll
    for (int o = 1; o < 64; o <<= 1) v += __shfl_xor(v, o);
    return v;
}
__device__ __forceinline__ float wave_max(float v) {
#pragma unroll
    for (int o = 1; o < 64; o <<= 1) v = fmaxf(v, __shfl_xor(v, o));
    return v;
}
namespace pg8 {
#define PG8_LAS __attribute__((address_space(3)))
typedef unsigned short bf16_t;
typedef short bf16x8 __attribute__((ext_vector_type(8)));
typedef float f32x4 __attribute__((ext_vector_type(4)));
typedef unsigned u32x4 __attribute__((ext_vector_type(4)));
constexpr int BM = 256, BK = 64, HALF = 128, HTB = HALF * BK * 2  , STAGE_BYTES = 8 * HTB, NXCD = 8, WGM = 8;

__host__ __device__ __forceinline__ int lds_byte(int r, int c) { const int st = (r >> 4) * 2 + (c >> 5), rr = r & 15, cc = c & 31, ob = rr * 64 + cc * 2; return st * 1024 + (ob ^ (((ob >> 9) & 1) << 5)); }
__host__ __device__ __forceinline__ void stage_rc(int b, int& R, int& C) { const int st = b / 1024, sb = b % 1024, swz = sb ^ (((sb >> 9) & 1) << 5); R = (st >> 1) * 16 + swz / 64; C = (st & 1) * 32 + (swz % 64) / 2; }
__host__ __device__ __forceinline__ int perm32(int rho) { const int n = rho >> 4, i = rho & 15; return 8 * (i >> 2) + 4 * n + (i & 3); }

struct Unit { int pm, pn; };
struct Gemm { const bf16_t* A; const bf16_t* Bt; int M, N, K; };

struct StaticOrder {
    int nM, nN, nwg, G, c;
    __host__ __device__ void init(int M, int N, int G_, int c_) { nM = M / BM; nN = N / BM; nwg = nM * nN; G = G_; c = c_; }
    __host__ __device__ bool next(int i, Unit& u) const {
        const long L = (long)i * G + c; if (L >= nwg) return false;
        int wgid = (int)L; { const int q = nwg / NXCD, r = nwg % NXCD, xcd = wgid % NXCD, off = wgid / NXCD; wgid = (xcd < r ? xcd * (q + 1) : r * (q + 1) + (xcd - r) * q) + off; }
        const int nig = WGM * nN, gid = wgid / nig, fm = gid * WGM, gsz = (nM - fm) < WGM ? (nM - fm) : WGM;
        u.pm = fm + ((wgid % nig) % gsz); u.pn = (wgid % nig) / gsz; return true;
    }
    __device__ __forceinline__ void a_ready(const Unit&) const {}
    __device__ __forceinline__ void done(const Unit&) const {}
};

__device__ __forceinline__ unsigned cvt_pk_bf16(float lo, float hi) { unsigned r; asm volatile("v_cvt_pk_bf16_f32 %0, %1, %2" : "=v"(r) : "v"(lo), "v"(hi)); return r; }
typedef float f32x2 __attribute__((ext_vector_type(2)));
typedef unsigned u32x2 __attribute__((ext_vector_type(2)));
struct EpiInProj {
    static constexpr bool PERM = true, AFTER_DRAIN = false;
    bf16_t *QS, *VR, *GS, *QA, *KA, *VA; float* G; float* kout; float* vout; const float* lbp;
    __device__ __forceinline__ void operator()(const f32x4 (&acc)[2][2][4][2], const Unit& u, int wr, int wc, int fr, int fq) const {
        const int grp = u.pn >> 1;
        const int cb = (u.pn & 1) * 256 + wc * 32 + 8 * fq;
        const int row0 = u.pm * BM + wr * 64 + fr;
        if (grp == 1) {
            float lb[2][8];
#pragma unroll
            for (int bj = 0; bj < 2; ++bj)
#pragma unroll
                for (int e = 0; e < 8; ++e) { const int c = cb + bj * HALF + e; lb[bj][e] = ::sigm(lbp[c] - lbp[512 + c]); }
#pragma unroll
            for (int ai = 0; ai < 2; ++ai)
#pragma unroll
                for (int m = 0; m < 4; ++m) { const size_t row = (size_t)(row0 + ai * HALF + m * 16);
#pragma unroll
                    for (int bj = 0; bj < 2; ++bj) { const f32x4 v0 = acc[ai][bj][m][0], v1 = acc[ai][bj][m][1]; f32x4 g0, g1;
#pragma unroll
                        for (int e = 0; e < 4; ++e) { const float f0 = lb[bj][e] + (1.0f - lb[bj][e]) * ::sigm(v0[e]), f1 = lb[bj][4 + e] + (1.0f - lb[bj][4 + e]) * ::sigm(v1[e]);
                            g0[e] = __builtin_amdgcn_logf(f0) * LN2; g1[e] = __builtin_amdgcn_logf(f1) * LN2; }
                        float* gp = G + row * 512 + cb + bj * HALF; *(f32x4*)gp = g0; *(f32x4*)(gp + 4) = g1; } }
        } else {
            bf16_t* dst = grp == 0 ? QS : grp == 2 ? VR : grp == 3 ? GS : grp == 4 ? QA : grp == 5 ? KA : VA;
            float* fo = grp == 5 ? kout : grp == 6 ? vout : nullptr;
            const bool act = (grp == 0 || grp == 3);
#pragma unroll
            for (int ai = 0; ai < 2; ++ai)
#pragma unroll
                for (int m = 0; m < 4; ++m) { const size_t row = (size_t)(row0 + ai * HALF + m * 16);
#pragma unroll
                    for (int bj = 0; bj < 2; ++bj) { f32x4 v0 = acc[ai][bj][m][0], v1 = acc[ai][bj][m][1];
                        const size_t off = row * 512 + cb + bj * HALF;
                        if (fo) { *(f32x4*)(fo + off) = v0; *(f32x4*)(fo + off + 4) = v1; }
                        if (act) {
#pragma unroll
                            for (int e = 0; e < 4; ++e) { v0[e] = ::siluf(v0[e]); v1[e] = ::siluf(v1[e]); } }
                        u32x4 w; w.x = cvt_pk_bf16(v0[0], v0[1]); w.y = cvt_pk_bf16(v0[2], v0[3]); w.z = cvt_pk_bf16(v1[0], v1[1]); w.w = cvt_pk_bf16(v1[2], v1[3]);
                        *(u32x4*)(dst + off) = w; } }
        }
    }
};
struct EpiWout {
    static constexpr bool PERM = false, AFTER_DRAIN = false;
    const float* X; float* X1; bf16_t* XB; float* PS1;
    __device__ __forceinline__ void operator()(const f32x4 (&acc)[2][2][4][2], const Unit& u, int wr, int wc, int fr, int fq) const {
        const int row0 = u.pm * BM + wr * 64 + fr, col0 = u.pn * BM + wc * 32 + 4 * fq;
#pragma unroll
        for (int ai = 0; ai < 2; ++ai)
#pragma unroll
            for (int m = 0; m < 4; ++m) { const size_t row = (size_t)(row0 + ai * HALF + m * 16); float ss = 0.f;
#pragma unroll
                for (int bj = 0; bj < 2; ++bj)
#pragma unroll
                    for (int n = 0; n < 2; ++n) { const size_t off = row * 1024 + col0 + bj * HALF + n * 16;
                        const f32x4 v = *(const f32x4*)(X + off) + acc[ai][bj][m][n]; *(f32x4*)(X1 + off) = v;
                        u32x2 w; w.x = cvt_pk_bf16(v[0], v[1]); w.y = cvt_pk_bf16(v[2], v[3]); *(u32x2*)(XB + off) = w;
                        ss += (v[0] * v[0] + v[1] * v[1]) + (v[2] * v[2] + v[3] * v[3]); }
                ss += __shfl_xor(ss, 16); ss += __shfl_xor(ss, 32);
                if (fq == 0) PS1[row * 16 + u.pn * 4 + wc] = ss; }
    }
};
struct EpiGateUp {
    static constexpr bool PERM = true, AFTER_DRAIN = false;
    const float* PS1; bf16_t* H;
    __device__ __forceinline__ void operator()(const f32x4 (&acc)[2][2][4][2], const Unit& u, int wr, int wc, int fr, int fq) const {
        const int row0 = u.pm * BM + wr * 64 + fr, f0 = (u.pn * BM + wc * 32 + 8 * fq) >> 1;
#pragma unroll
        for (int ai = 0; ai < 2; ++ai)
#pragma unroll
            for (int m = 0; m < 4; ++m) { const size_t row = (size_t)(row0 + ai * HALF + m * 16);
                const f32x4 p0 = *(const f32x4*)(PS1 + row * 16), p1 = *(const f32x4*)(PS1 + row * 16 + 4), p2 = *(const f32x4*)(PS1 + row * 16 + 8), p3 = *(const f32x4*)(PS1 + row * 16 + 12);
                const f32x4 ps = (p0 + p1) + (p2 + p3);
                const float rstd = __builtin_amdgcn_rsqf(((ps[0] + ps[1]) + (ps[2] + ps[3])) * (1.0f / 1024.0f) + EPS);
#pragma unroll
                for (int bj = 0; bj < 2; ++bj) { const f32x4 g = acc[ai][bj][m][0] * rstd, uu = acc[ai][bj][m][1] * rstd;
                    u32x2 w; w.x = cvt_pk_bf16(::siluf(g[0]) * uu[0], ::siluf(g[1]) * uu[1]); w.y = cvt_pk_bf16(::siluf(g[2]) * uu[2], ::siluf(g[3]) * uu[3]);
                    *(u32x2*)(H + row * 2816 + f0 + bj * 64) = w; } }
    }
};
struct EpiDown {
    static constexpr bool PERM = false, AFTER_DRAIN = false;
    const float* X1; float* OUT;
    __device__ __forceinline__ void operator()(const f32x4 (&acc)[2][2][4][2], const Unit& u, int wr, int wc, int fr, int fq) const {
        const int row0 = u.pm * BM + wr * 64 + fr, col0 = u.pn * BM + wc * 32 + 4 * fq;
#pragma unroll
        for (int ai = 0; ai < 2; ++ai)
#pragma unroll
            for (int m = 0; m < 4; ++m) { const size_t row = (size_t)(row0 + ai * HALF + m * 16);
#pragma unroll
                for (int bj = 0; bj < 2; ++bj)
#pragma unroll
                    for (int n = 0; n < 2; ++n) { const size_t off = row * 1024 + col0 + bj * HALF + n * 16;
                        *(f32x4*)(OUT + off) = *(const f32x4*)(X1 + off) + acc[ai][bj][m][n]; } }
    }
};
template <class Epi, class Sched, bool ALIGN_EPI = false, bool SP2 = false>
__device__ __forceinline__ void gemm_phase(PG8_LAS unsigned char* lds, const Gemm g, const Sched& S, const Epi& E) {
    const int tid = threadIdx.x, wid = __builtin_amdgcn_readfirstlane(tid >> 6), lane = tid & 63, wr = wid >> 2, wc = wid & 3, fr = lane & 15, fq = lane >> 4;
    const int K = g.K, nt = K / BK;
    unsigned voffA[2], voffB[2];
#pragma unroll
    for (int i = 0; i < 2; ++i) { int R, C; stage_rc(tid * 16 + i * 8192, R, C); const int Rb = Epi::PERM ? ((R & ~31) + perm32(R & 31)) : R;
        voffA[i] = (unsigned)(R * K + C) * 2u; voffB[i] = (unsigned)(Rb * K + C) * 2u; }
    const size_t kstep = (size_t)(BK * 2);
    const size_t hstep = (size_t)HALF * K * 2;
    const size_t tstep = 2 * hstep;
    const unsigned ldsw = (unsigned)wid * 1024u;
    const int aoff = lds_byte(wr * 64 + fr, fq * 8), boff = lds_byte(wc * 32 + fr, fq * 8);
#define PG8_SA(b, h) (((b) * 2 + (h)) * HTB)
#define PG8_SB(b, h) ((4 + (b) * 2 + (h)) * HTB)
#define PG8_STAGE(bufoff, gbase, voff) do { _Pragma("unroll") for (int _i = 0; _i < 2; ++_i) \
        __builtin_amdgcn_global_load_lds((const unsigned*)((const char*)(gbase) + (voff)[_i]), (PG8_LAS unsigned*)(lds + (bufoff) + ldsw + _i * 8192), 16, 0, 0); } while (0)
#define PG8_LDA(dst, b, h) do { _Pragma("unroll") for (int m = 0; m < 4; ++m) _Pragma("unroll") for (int k = 0; k < 2; ++k) dst[m][k] = *(const PG8_LAS bf16x8*)(lds + PG8_SA(b, h) + aoff + m * 2048 + k * 1024); } while (0)
#define PG8_LDB(dst, b, h) do { _Pragma("unroll") for (int n = 0; n < 2; ++n) _Pragma("unroll") for (int k = 0; k < 2; ++k) dst[n][k] = *(const PG8_LAS bf16x8*)(lds + PG8_SB(b, h) + boff + n * 2048 + k * 1024); } while (0)
#define PG8_MMA(ai, bj, At, Bt) do { __builtin_amdgcn_s_setprio(1); _Pragma("unroll") for (int m = 0; m < 4; ++m) _Pragma("unroll") for (int n = 0; n < 2; ++n) _Pragma("unroll") for (int k = 0; k < 2; ++k) \
        acc[ai][bj][m][n] = __builtin_amdgcn_mfma_f32_16x16x32_bf16(Bt[n][k], At[m][k], acc[ai][bj][m][n], 0, 0, 0); __builtin_amdgcn_s_setprio(0); } while (0)
#define PG8_WAIT_V(n) asm volatile("s_waitcnt vmcnt(" #n ")" ::: "memory")
#define PG8_WAIT_L(n) asm volatile("s_waitcnt lgkmcnt(" #n ")" ::: "memory")
#define PG8_BAR __builtin_amdgcn_s_barrier()
#define PG8_SCHED __builtin_amdgcn_sched_barrier(0)
    Unit cur, nxt; int ui = 0;
    if (!S.next(0, cur)) return;
    f32x4 acc[2][2][4][2];
#pragma unroll
    for (int a = 0; a < 2; ++a)
#pragma unroll
        for (int b = 0; b < 2; ++b)
#pragma unroll
            for (int m = 0; m < 4; ++m)
#pragma unroll
                for (int n = 0; n < 2; ++n) acc[a][b][m][n] = (f32x4){0.f, 0.f, 0.f, 0.f};
    bf16x8 At[4][2], B0[2][2], B1[2][2];
    const char* cA = (const char*)g.A + (size_t)cur.pm * tstep; const char* cB = (const char*)g.Bt + (size_t)cur.pn * tstep;
    S.a_ready(cur);
    if constexpr (SP2) {
        PG8_STAGE(PG8_SB(0, 0), cB, voffB); PG8_STAGE(PG8_SB(0, 1), cB + hstep, voffB); PG8_STAGE(PG8_SA(0, 0), cA, voffA); PG8_STAGE(PG8_SA(0, 1), cA + hstep, voffA);
        if (wr == 1) PG8_BAR;
        PG8_WAIT_V(2); PG8_BAR;
        PG8_STAGE(PG8_SB(1, 0), cB + kstep, voffB); PG8_STAGE(PG8_SA(1, 0), cA + kstep, voffA); PG8_STAGE(PG8_SB(1, 1), cB + hstep + kstep, voffB);
        PG8_WAIT_V(6); PG8_BAR;
    } else {
        PG8_STAGE(PG8_SB(0, 0), cB, voffB); PG8_STAGE(PG8_SA(0, 0), cA, voffA); PG8_STAGE(PG8_SB(0, 1), cB + hstep, voffB); PG8_STAGE(PG8_SA(0, 1), cA + hstep, voffA);
        if (wr == 1) PG8_BAR;
        PG8_WAIT_V(4); PG8_BAR;
        PG8_STAGE(PG8_SB(1, 0), cB + kstep, voffB); PG8_STAGE(PG8_SA(1, 0), cA + kstep, voffA); PG8_STAGE(PG8_SB(1, 1), cB + hstep + kstep, voffB);
        PG8_WAIT_V(6); PG8_BAR;
    }
    for (;;) {
        const bool has_next = S.next(ui + 1, nxt);
        const char* nA = has_next ? (const char*)g.A + (size_t)nxt.pm * tstep : cA; const char* nB = has_next ? (const char*)g.Bt + (size_t)nxt.pn * tstep : cB;
        for (int t = 0; t < nt; t += 2) {
            const bool last = (t == nt - 2);
            const char* a1 = cA + (size_t)(t + 1) * kstep;
            const char* a2 = last ? nA : cA + (size_t)(t + 2) * kstep; const char* b2 = last ? nB : cB + (size_t)(t + 2) * kstep;
            const char* a3 = a2 + kstep; const char* b3 = b2 + kstep;
            if (last && has_next) S.a_ready(nxt);
            if constexpr (SP2) {
            PG8_LDB(B0, 0, 0); PG8_LDB(B1, 0, 1); PG8_SCHED; PG8_LDA(At, 0, 0); PG8_STAGE(PG8_SA(1, 1), a1 + hstep, voffA);
            PG8_WAIT_V(8); PG8_WAIT_L(0); PG8_BAR; PG8_MMA(0, 0, At, B0); PG8_MMA(0, 1, At, B1); PG8_BAR; PG8_SCHED;
            PG8_LDA(At, 0, 1); PG8_STAGE(PG8_SB(0, 0), b2, voffB); PG8_STAGE(PG8_SB(0, 1), b2 + hstep, voffB); PG8_STAGE(PG8_SA(0, 0), a2, voffA);
            PG8_WAIT_V(8); PG8_WAIT_L(0); PG8_BAR; PG8_MMA(1, 0, At, B0); PG8_MMA(1, 1, At, B1); PG8_BAR; PG8_SCHED;
            PG8_LDB(B0, 1, 0); PG8_LDB(B1, 1, 1); PG8_SCHED; PG8_LDA(At, 1, 0); PG8_STAGE(PG8_SA(0, 1), a2 + hstep, voffA);
            PG8_WAIT_V(8); PG8_WAIT_L(0); PG8_BAR; PG8_MMA(0, 0, At, B0); PG8_MMA(0, 1, At, B1); PG8_BAR; PG8_SCHED;
            PG8_LDA(At, 1, 1); PG8_STAGE(PG8_SB(1, 0), b3, voffB); PG8_STAGE(PG8_SB(1, 1), b3 + hstep, voffB); PG8_STAGE(PG8_SA(1, 0), a3, voffA);
            PG8_WAIT_V(8); PG8_WAIT_L(0); PG8_BAR; PG8_MMA(1, 0, At, B0); PG8_MMA(1, 1, At, B1); PG8_BAR; PG8_SCHED;
            } else {
            PG8_LDB(B0, 0, 0); PG8_SCHED; PG8_LDA(At, 0, 0); PG8_STAGE(PG8_SA(1, 1), a1 + hstep, voffA);
            PG8_WAIT_L(8); PG8_BAR; PG8_WAIT_L(0); PG8_MMA(0, 0, At, B0); PG8_BAR; PG8_SCHED;
            PG8_LDB(B1, 0, 1); PG8_STAGE(PG8_SB(0, 0), b2, voffB);
            PG8_BAR; PG8_WAIT_L(0); PG8_MMA(0, 1, At, B1); PG8_BAR;
            PG8_LDA(At, 0, 1); PG8_STAGE(PG8_SA(0, 0), a2, voffA);
            PG8_BAR; PG8_WAIT_L(0); PG8_MMA(1, 0, At, B0); PG8_BAR; PG8_SCHED;
            PG8_STAGE(PG8_SB(0, 1), b2 + hstep, voffB);
            PG8_WAIT_V(6); PG8_BAR; PG8_MMA(1, 1, At, B1); PG8_BAR;
            PG8_LDB(B0, 1, 0); PG8_SCHED; PG8_LDA(At, 1, 0); PG8_STAGE(PG8_SA(0, 1), a2 + hstep, voffA);
            PG8_WAIT_L(8); PG8_BAR; PG8_WAIT_L(0); PG8_MMA(0, 0, At, B0); PG8_BAR; PG8_SCHED;
            PG8_LDB(B1, 1, 1); PG8_STAGE(PG8_SB(1, 0), b3, voffB);
            PG8_BAR; PG8_WAIT_L(0); PG8_MMA(0, 1, At, B1); PG8_BAR;
            PG8_LDA(At, 1, 1); PG8_STAGE(PG8_SA(1, 0), a3, voffA);
            PG8_BAR; PG8_WAIT_L(0); PG8_MMA(1, 0, At, B0); PG8_BAR; PG8_SCHED;
            PG8_STAGE(PG8_SB(1, 1), b3 + hstep, voffB);
            PG8_WAIT_V(6); PG8_BAR; PG8_MMA(1, 1, At, B1); PG8_BAR;
            }
        }
        if constexpr (ALIGN_EPI) { if (wr == 0) PG8_BAR; }
        if constexpr (!Epi::AFTER_DRAIN) { E(acc, cur, wr, wc, fr, fq); S.done(cur); }
        if (!has_next) break;
#pragma unroll
        for (int a = 0; a < 2; ++a)
#pragma unroll
            for (int b = 0; b < 2; ++b)
#pragma unroll
                for (int m = 0; m < 4; ++m)
#pragma unroll
                    for (int n = 0; n < 2; ++n) acc[a][b][m][n] = (f32x4){0.f, 0.f, 0.f, 0.f};
        cur = nxt; cA = nA; cB = nB; ++ui;
        if constexpr (ALIGN_EPI) { if (wr == 1) PG8_BAR; }
    }
    PG8_WAIT_V(0);
    if constexpr (!ALIGN_EPI) { if (wr == 0) PG8_BAR; }
    PG8_BAR;
    if constexpr (Epi::AFTER_DRAIN) { E.fused(acc, cur, wr, wc, fr, fq, lds, wid, lane); S.done(cur); }
#undef PG8_SA
#undef PG8_SB
#undef PG8_STAGE
#undef PG8_LDA
#undef PG8_LDB
#undef PG8_MMA
#undef PG8_WAIT_V
#undef PG8_WAIT_L
#undef PG8_BAR
#undef PG8_SCHED
}
}
namespace att {
typedef short s16x4 __attribute__((ext_vector_type(4)));
constexpr int NW = 8, QBLK = 32, KVBLK = 64, QB = 128, D = 128, PITCH = 512, OPITCH = 1024;
constexpr int SHM_V = KVBLK * D * 2, SHM_K = KVBLK * D * 2;
constexpr int LDS_WS = 2 * SHM_V + 2 * SHM_K, LDS_XCH = LDS_WS + NW * 64 * 4, LDS_BYTES = LDS_XCH + 4 * 32 * 128 * 4;
constexpr float SCALE = 0.125f, THR = 8.f;
constexpr unsigned WBIG = 0x40000000u;
#define KSWZ(row, colB) ((row) * 256 + ((colB) ^ (((row) & 7) << 4)))
#define SBAR() __builtin_amdgcn_sched_barrier(0)
__device__ __forceinline__ int v_st(int k, int c) { const int kk = (k & ~0xC) | ((k & 4) << 1) | ((k & 8) >> 1); return ((kk >> 3) * 4 + (c >> 5)) * 512 + ((kk & 7) * 32 + (c & 31)) * 2; }
__device__ __forceinline__ int v_rd_base(int lane) { return ((lane & 3) << 3) | (((lane >> 2) & 3) << 6) | (((lane >> 4) & 1) << 5) | (((lane >> 5) & 1) << 8); }
constexpr int v_rd_off(int d0, int ks, int half) { return d0 * 512 + ks * 4096 + half * 2048; }
__device__ __forceinline__ int crow(int r, int hi) { return (r & 3) + 8 * (r >> 2) + 4 * hi; }
__device__ __forceinline__ unsigned cvtpk(float lo, float hi) { unsigned r; asm volatile("v_cvt_pk_bf16_f32 %0, %1, %2" : "=v"(r) : "v"(lo), "v"(hi)); return r; }
__device__ __forceinline__ bf16x8 load8(const bf16* p) { return *reinterpret_cast<const bf16x8*>(p); }
__device__ __forceinline__ void mask_tile(f32x16& p0, f32x16& p1, int dq, unsigned W) {
    const float NEG = -__builtin_inff();
#pragma unroll
    for (int r = 0; r < 16; ++r) {
        const int c = (r & 3) + 8 * (r >> 2);
        if ((unsigned)(dq - c) >= W) p0[r] = NEG;
        if ((unsigned)(dq - c - 32) >= W) p1[r] = NEG;
    }
}
__device__ __forceinline__ void partialSM(f32x16& p0, f32x16& p1, float& m_reg, float& mn, float& alpha) {
    float pmax = p0[0];
#pragma unroll
    for (int r = 1; r < 16; ++r) pmax = fmaxf(pmax, p0[r]);
#pragma unroll
    for (int r = 0; r < 16; ++r) pmax = fmaxf(pmax, p1[r]);
    { auto rr = __builtin_amdgcn_permlane32_swap(__float_as_uint(pmax), __float_as_uint(pmax), false, false);
      pmax = fmaxf(__uint_as_float(rr[0]), __uint_as_float(rr[1])); }
    constexpr float C2 = 1.4426950408889634f * SCALE;
    if (__builtin_expect(__all((pmax - m_reg) * SCALE <= THR), 1)) { mn = m_reg; alpha = 1.f; }
    else { mn = fmaxf(m_reg, pmax); alpha = __builtin_amdgcn_exp2f((m_reg - mn) * C2); m_reg = mn; }
    const float mnL = -mn * C2;
#pragma unroll
    for (int r = 0; r < 16; ++r) p0[r] = fmaf(p0[r], C2, mnL);
#pragma unroll
    for (int r = 0; r < 16; ++r) p1[r] = fmaf(p1[r], C2, mnL);
#pragma unroll
    for (int r = 0; r < 16; ++r) p0[r] = __builtin_amdgcn_exp2f(p0[r]);
}
__device__ __forceinline__ void finishSM(f32x16& p0, f32x16& p1, float alpha, float& l_reg, bf16x8& pa0, bf16x8& pa1, bf16x8& pa2, bf16x8& pa3) {
#pragma unroll
    for (int r = 0; r < 16; ++r) p1[r] = __builtin_amdgcn_exp2f(p1[r]);
    float ps = 0;
#pragma unroll
    for (int r = 0; r < 16; ++r) ps += p0[r];
#pragma unroll
    for (int r = 0; r < 16; ++r) ps += p1[r];
    { auto rr = __builtin_amdgcn_permlane32_swap(__float_as_uint(ps), __float_as_uint(ps), false, false);
      ps = __uint_as_float(rr[0]) + __uint_as_float(rr[1]); }
    l_reg = l_reg * alpha + ps;
#define PK4(P, B_, OUT) do { unsigned a0 = cvtpk(P[B_+0], P[B_+1]), a1 = cvtpk(P[B_+2], P[B_+3]);                          \
        unsigned b0 = cvtpk(P[B_+4], P[B_+5]), b1 = cvtpk(P[B_+6], P[B_+7]);                                             \
        auto r0 = __builtin_amdgcn_permlane32_swap(a0, b0, false, false); auto r1 = __builtin_amdgcn_permlane32_swap(a1, b1, false, false); \
        v4u w = {r0[0], r1[0], r0[1], r1[1]}; OUT = *reinterpret_cast<bf16x8*>(&w); } while (0)
    PK4(p0, 0, pa0); PK4(p0, 8, pa1); PK4(p1, 0, pa2); PK4(p1, 8, pa3);
#undef PK4
}
template <int KB>
__device__ __forceinline__ void qkt(f32x16& p0, f32x16& p1, const char* K_lds, int r32, int hi, const bf16x8* qr, int kcolB) {
    p0 = f32x16{}; p1 = f32x16{};
#pragma unroll
    for (int d0 = 0; d0 < 4; ++d0) { const char* a = K_lds + KB * SHM_K + KSWZ(r32, (d0 * 16 + hi * 8) * 2 + kcolB);
        bf16x8 b0 = *reinterpret_cast<const bf16x8*>(a);
        bf16x8 b1 = *reinterpret_cast<const bf16x8*>(a + 32 * 256);
        p0 = __builtin_amdgcn_mfma_f32_32x32x16_bf16(b0, qr[d0], p0, 0, 0, 0);
        p1 = __builtin_amdgcn_mfma_f32_32x32x16_bf16(b1, qr[d0], p1, 0, 0, 0); }
}
template <int VB>
__device__ __forceinline__ void pv_tile(f32x16* o, int vb0, bf16x8 pa0, bf16x8 pa1, bf16x8 pa2, bf16x8 pa3) {
#define TRRD(dst, off) asm volatile("ds_read_b64_tr_b16 %0, %1 offset:%2" : "=&v"(dst) : "v"(vb0), "i"(off) : "memory")
#define PV_D0(d0) do { s16x4 l0, l1, l2, l3, h0, h1, h2, h3; constexpr int b_ = VB * SHM_V + v_rd_off(d0, 0, 0);     \
        TRRD(l0, b_); TRRD(h0, b_ + 2048); TRRD(l1, b_ + 4096); TRRD(h1, b_ + 6144); TRRD(l2, b_ + 8192); TRRD(h2, b_ + 10240); TRRD(l3, b_ + 12288); TRRD(h3, b_ + 14336); \
        asm volatile("s_waitcnt lgkmcnt(0)" ::: "memory"); SBAR();                 \
        o[d0] = __builtin_amdgcn_mfma_f32_32x32x16_bf16(pa0, (bf16x8){l0[0], l0[1], l0[2], l0[3], h0[0], h0[1], h0[2], h0[3]}, o[d0], 0, 0, 0);   \
        o[d0] = __builtin_amdgcn_mfma_f32_32x32x16_bf16(pa1, (bf16x8){l1[0], l1[1], l1[2], l1[3], h1[0], h1[1], h1[2], h1[3]}, o[d0], 0, 0, 0);   \
        o[d0] = __builtin_amdgcn_mfma_f32_32x32x16_bf16(pa2, (bf16x8){l2[0], l2[1], l2[2], l2[3], h2[0], h2[1], h2[2], h2[3]}, o[d0], 0, 0, 0);   \
        o[d0] = __builtin_amdgcn_mfma_f32_32x32x16_bf16(pa3, (bf16x8){l3[0], l3[1], l3[2], l3[3], h3[0], h3[1], h3[2], h3[3]}, o[d0], 0, 0, 0); } while (0)
    PV_D0(0); PV_D0(1); PV_D0(2); PV_D0(3);
#undef PV_D0
#undef TRRD
}
struct BlockRef { const bf16* Q; const bf16* K; const bf16* V; bf16* O; int P0; };
struct Seam { bf16x8 qr[4]; bf16x8 sv0, sv1, sk0, sk1; };
struct Consts { float lam, oscale; const float* subln; };
#define AROW(p, k0, rr) ((p) + (size_t)((k0) + (rr)) * PITCH + sc)
#define LOADK(Kp, kb) do { S.sk0 = load8(AROW(Kp, kb, sr)); S.sk1 = load8(AROW(Kp, kb, 32 + sr)); } while (0)
#define LOADV(Vp, kb) do { S.sv0 = load8(AROW(Vp, kb, sr)); S.sv1 = load8(AROW(Vp, kb, 32 + sr)); } while (0)
#define WRITEK(bf) do { *(bf16x8*)(K_lds + (bf) * SHM_K + kws) = S.sk0; *(bf16x8*)(K_lds + (bf) * SHM_K + kws + 32 * 256) = S.sk1; } while (0)
#define WRITEV(bf) do { *(bf16x8*)(V_lds + (bf) * SHM_V + vst0) = S.sv0; *(bf16x8*)(V_lds + (bf) * SHM_V + vst1) = S.sv1; } while (0)
__device__ __forceinline__ void prime(const BlockRef& cur, char* lds, Seam& S) {
    const int tid = threadIdx.x, wid = __builtin_amdgcn_readfirstlane(tid >> 6), lane = tid & 63, r32 = lane & 31, hi = lane >> 5;
    const int mw = wid >> 2, wq = wid & 3;
    const int sr = tid >> 4, sc = (tid & 15) * 8, kws = KSWZ(sr, sc * 2); char* K_lds = lds + 2 * SHM_V;
    LOADK(cur.K, 0);
#pragma unroll
    for (int d0 = 0; d0 < 4; ++d0) S.qr[d0] = load8(cur.Q + (size_t)(wq * QBLK + r32) * PITCH + mw * 64 + d0 * 16 + hi * 8);
    WRITEK(0); SBAR();
    LOADK(cur.K, KVBLK); LOADV(cur.V, 0);
    __syncthreads();
}
__device__ __forceinline__ void block(const BlockRef& cur, const BlockRef& nxt, char* lds, Seam& S, const Consts& C) {
    const int tid = threadIdx.x, wid = __builtin_amdgcn_readfirstlane(tid >> 6), lane = tid & 63, r32 = lane & 31, hi = lane >> 5;
    const int mw = wid >> 2, wq = wid & 3;
    const int NT = cur.P0 / KVBLK + 2;
    const int qlo = cur.P0 + wq * QBLK, qm = qlo + r32 - 4 * hi;
    char* V_lds = lds; char* K_lds = lds + 2 * SHM_V;
    float* ws = (float*)(lds + LDS_WS) + wid * 64; float* li_l = ws, * al_l = ws + 32;
    float m_reg = -1e30f, l_reg = 0; f32x16 o[4] = {};
    const int sr = tid >> 4, sc = (tid & 15) * 8, vst0 = v_st(sr, sc), vst1 = v_st(32 + sr, sc), kws = KSWZ(sr, sc * 2);
    const int vb0 = (int)(uintptr_t)V_lds + v_rd_base(lane);
    const int kcolB = mw * 128;
    const bf16* Kh = cur.K; const bf16* Vh = cur.V;
#define RESC(a) do { if (__any((a) < 1.f)) { if (hi == 0) al_l[r32] = (a); asm volatile("s_waitcnt lgkmcnt(0)" ::: "memory");              \
                     for (int d_ = 0; d_ < 4; ++d_) for (int r = 0; r < 16; ++r) o[d_][r] *= al_l[crow(r, hi)]; } } while (0)
#define KBASE(t) ((t) * KVBLK)
#define MASKT(P0_, P1_, t) do { const int kb_ = KBASE(t); if (kb_ + KVBLK - 1 > qlo) mask_tile(P0_, P1_, qm - kb_, WBIG); } while (0)
    f32x16 pA0, pA1, pB0, pB1; float mnA, mnB, alA, alB; bf16x8 pa0, pa1, pa2, pa3;
    SBAR(); qkt<0>(pA0, pA1, K_lds, r32, hi, S.qr, kcolB);
    MASKT(pA0, pA1, 0); partialSM(pA0, pA1, m_reg, mnA, alA);
    WRITEK(1); WRITEV(0); SBAR();
    if (2 < NT) LOADK(Kh, KBASE(2));
    LOADV(Vh, KBASE(1));
    __syncthreads();
#define HALF_STEP(PX0, PX1, mnX, alX, PY0, PY1, alY, t, KB, VB) do {                                                          \
        SBAR(); qkt<KB>(PX0, PX1, K_lds, r32, hi, S.qr, kcolB);                                                               \
        finishSM(PY0, PY1, alY, l_reg, pa0, pa1, pa2, pa3); SBAR();                                                           \
        pv_tile<VB>(o, vb0, pa0, pa1, pa2, pa3); MASKT(PX0, PX1, (t)); partialSM(PX0, PX1, m_reg, mnX, alX);                  \
        __syncthreads();                                                                                                      \
        WRITEK(VB); WRITEV(KB); SBAR();                                                                                       \
        if ((t) + 2 < NT) LOADK(Kh, KBASE((t) + 2));                                                                          \
        LOADV(Vh, KBASE((t) + 1)); SBAR();                                                                                    \
        RESC(alX); __syncthreads(); } while (0)
    for (int t = 1; t + 1 < NT; t += 2) {
        HALF_STEP(pB0, pB1, mnB, alB, pA0, pA1, alA, t, 1, 0);
        HALF_STEP(pA0, pA1, mnA, alA, pB0, pB1, alB, t + 1, 0, 1);
    }
    SBAR(); qkt<1>(pB0, pB1, K_lds, r32, hi, S.qr, kcolB); SBAR();
    LOADK(nxt.K, 0); SBAR();
#pragma unroll
    for (int d0 = 0; d0 < 4; ++d0) S.qr[d0] = load8(nxt.Q + (size_t)(wq * QBLK + r32) * PITCH + mw * 64 + d0 * 16 + hi * 8);
    SBAR();
    finishSM(pA0, pA1, alA, l_reg, pa0, pa1, pa2, pa3); SBAR();
    pv_tile<0>(o, vb0, pa0, pa1, pa2, pa3);
    MASKT(pB0, pB1, NT - 1); partialSM(pB0, pB1, m_reg, mnB, alB);
    __syncthreads();
    WRITEV(1); WRITEK(0); SBAR();
    LOADK(nxt.K, KVBLK); LOADV(nxt.V, 0); SBAR();
    RESC(alB); __syncthreads();
    finishSM(pB0, pB1, alB, l_reg, pa0, pa1, pa2, pa3); SBAR(); pv_tile<1>(o, vb0, pa0, pa1, pa2, pa3);
    int r32e = r32, hie = hi; asm volatile("" : "+v"(r32e), "+v"(hie));
    if (hie == 0) li_l[r32e] = l_reg; asm volatile("s_waitcnt lgkmcnt(0)" ::: "memory");
    float rli[16];
#pragma unroll
    for (int r = 0; r < 16; ++r) rli[r] = __builtin_amdgcn_rcpf(li_l[crow(r, hie)]);
    float* xch = (float*)(lds + LDS_XCH) + wq * (32 * 128);
    if (mw == 1) {
#pragma unroll
        for (int r = 0; r < 16; ++r) { const int orow = crow(r, hie);
#pragma unroll
            for (int d0 = 0; d0 < 4; ++d0) xch[orow * 128 + d0 * 32 + r32e] = o[d0][r] * rli[r]; }
    }
    __syncthreads();
    if (mw == 0) {
        bf16* Ow = cur.O + (size_t)(wq * QBLK) * OPITCH;
        float sub[4];
#pragma unroll
        for (int d0 = 0; d0 < 4; ++d0) sub[d0] = C.subln[d0 * 32 + r32e];
#pragma unroll
        for (int r = 0; r < 16; ++r) { const int orow = crow(r, hie); float a[4]; float ss = 0.f;
#pragma unroll
            for (int d0 = 0; d0 < 4; ++d0) { a[d0] = o[d0][r] * rli[r] - C.lam * xch[orow * 128 + d0 * 32 + r32e]; ss += a[d0] * a[d0]; }
#pragma unroll
            for (int ofs = 1; ofs < 32; ofs <<= 1) ss += __shfl_xor(ss, ofs);
            const float rs = __builtin_amdgcn_rsqf(ss * (1.0f / 128.0f) + EPS) * C.oscale;
#pragma unroll
            for (int d0 = 0; d0 < 4; ++d0) { const float v = a[d0] * rs * sub[d0]; const float vn = __shfl_xor(v, 1);
                if ((r32e & 1) == 0) *(unsigned*)(Ow + (size_t)orow * OPITCH + d0 * 32 + r32e) = cvtpk(v, vn); } }
    }
    __syncthreads();
#undef RESC
#undef KBASE
#undef MASKT
#undef HALF_STEP
}
__device__ __forceinline__ BlockRef mkref(int L, int pass, const bf16* QA, const bf16* KA, const bf16* VA, bf16* MRG) {
    const int bh = L & 7, b = bh >> 2, h = bh & 3, y = L >> 3, qb = pass ? y : 63 - y;
    BlockRef r; r.P0 = qb * QB;
    r.Q = QA + ((size_t)b * SEQ + r.P0) * PITCH + h * 128; r.K = KA + (size_t)b * SEQ * PITCH + h * 128; r.V = VA + (size_t)b * SEQ * PITCH + h * 128;
    r.O = MRG + ((size_t)b * SEQ + r.P0) * OPITCH + 512 + h * 128;
    return r;
}
__device__ __forceinline__ void attn_phase(char* lds, const bf16* QA, const bf16* KA, const bf16* VA, bf16* MRG, const Consts& C, int G, int bx) {
    constexpr int total = 256;
    int L = bx; if (L >= total) return;
    int pass = 0;
    BlockRef cur = mkref(L, 0, QA, KA, VA, MRG);
    Seam S;
    prime(cur, lds, S);
    for (;;) {
        const bool more_pass = pass == 0, more_item = L + G < total, last = !more_pass && !more_item;
        int passn = pass + 1, Ln = L;
        if (!more_pass) { passn = 0; Ln = more_item ? L + G : L; }
        const BlockRef nxt = last ? cur : mkref(Ln, passn, QA, KA, VA, MRG);
        block(cur, nxt, lds, S, C);
        if (last) break;
        cur = nxt; pass = passn; L = Ln;
    }
}
#undef AROW
#undef LOADK
#undef LOADV
#undef WRITEK
#undef WRITEV
#undef KSWZ
#undef SBAR
}
#define XB_TMO      128
#define XB_XCNT(j)  (256  + 64 * (j))
#define XB_XSUB(j)  (1280 + 64 * (j))
#define XB_XGEN(j)  (2304 + 64 * (j))
#define XB_TOP      3328
#define XB_TOPGEN   3392
#define XCD_BAR_WORDS 3456
#define XB_SPIN_CAP (1u << 18)

__device__ __forceinline__ unsigned xb_ld(unsigned* p)              { return __hip_atomic_load(p, __ATOMIC_RELAXED, __HIP_MEMORY_SCOPE_AGENT); }
__device__ __forceinline__ unsigned xb_add(unsigned* p, unsigned v) { return __hip_atomic_fetch_add(p, v, __ATOMIC_RELAXED, __HIP_MEMORY_SCOPE_AGENT); }
__device__ __forceinline__ unsigned xb_xcc_id() { return (unsigned)__builtin_amdgcn_s_getreg((3 << 11) | 20) & 0xFu; }
#define XB_SPIN(cond, bar) do { unsigned _sp = 0; while (cond) { __builtin_amdgcn_s_sleep(1); \
    if ((++_sp & 255u) == 0u) { if (xb_ld(&(bar)[XB_TMO])) break; if (_sp > XB_SPIN_CAP) { atomicAdd(&(bar)[XB_TMO], 1u); break; } } } } while (0)

struct XcdBarrier {
    unsigned* bar; unsigned x;
    volatile LAS unsigned* st;
};

__device__ __forceinline__ XcdBarrier xcd_barrier_post(unsigned* bar, volatile LAS unsigned* st) {
    XcdBarrier b; b.bar = bar; b.x = xb_xcc_id(); b.st = st;
    if (threadIdx.x == 0) (void)xb_add(&bar[XB_XCNT(b.x)], 1u);
    return b;
}
__device__ __forceinline__ void xcd_barrier_complete(unsigned* bar, unsigned x, unsigned& nloc, unsigned& nx) {
    const unsigned G = gridDim.x * gridDim.y * gridDim.z;
    unsigned sum, cnt, mine, sp = 0u;
    for (;;) {
        sum = 0u; cnt = 0u; mine = 0u;
#pragma unroll
        for (unsigned j = 0; j < 16; ++j) { const unsigned c = xb_ld(&bar[XB_XCNT(j)]); sum += c; cnt += (c > 0u) ? 1u : 0u; mine = (j == x) ? c : mine; }
        if (sum == G) break;
        __builtin_amdgcn_s_sleep(1);
        if ((++sp & 255u) == 0u) { if (xb_ld(&bar[XB_TMO])) break; if (sp > XB_SPIN_CAP) { atomicAdd(&bar[XB_TMO], 1u); break; } }
    }
    nloc = mine > 0u ? mine : 1u; nx = cnt > 0u ? cnt : 1u;
}

__device__ __forceinline__ void xcd_barrier(const XcdBarrier& b) {
    asm volatile("s_waitcnt vmcnt(0)" ::: "memory");
    __syncthreads();
    if (threadIdx.x == 0) {
        unsigned* bar = b.bar;
        __builtin_amdgcn_s_waitcnt(0);
        unsigned nloc = b.st[0], nx = b.st[1];
        if (nloc == 0u) { xcd_barrier_complete(bar, b.x, nloc, nx); b.st[0] = nloc; b.st[1] = nx; }
        const unsigned old = xb_add(&bar[XB_XSUB(b.x)], 1u);
        const unsigned gen = old / nloc;
        if (old + 1u == (gen + 1u) * nloc) {
            __builtin_amdgcn_fence(__ATOMIC_RELEASE, "agent");
            asm volatile("s_waitcnt vmcnt(0)" ::: "memory");
            const unsigned og = xb_add(&bar[XB_TOP], 1u);
            const unsigned tg = og / nx;
            if (og + 1u == (tg + 1u) * nx) xb_add(&bar[XB_TOPGEN], 1u);
            else XB_SPIN(xb_ld(&bar[XB_TOPGEN]) == tg, bar);
            __builtin_amdgcn_fence(__ATOMIC_ACQUIRE, "agent");
            xb_add(&bar[XB_XGEN(b.x)], 1u);
            asm volatile("s_waitcnt vmcnt(0)" ::: "memory");
        } else {
            XB_SPIN(xb_ld(&bar[XB_XGEN(b.x)]) == gen, bar);
            __builtin_amdgcn_fence(__ATOMIC_ACQUIRE, "agent");
            asm volatile("s_waitcnt vmcnt(0)" ::: "memory");
        }
    }
    __syncthreads();
}
constexpr int NWAVES = 8;
__device__ __forceinline__ f32x16 mfma32(bf16x8 a, bf16x8 b, f32x16 c) { return __builtin_amdgcn_mfma_f32_32x32x16_bf16(a, b, c, 0, 0, 0); }
__device__ __forceinline__ int crow32(int r, int hi) { return (r & 3) + 8 * (r >> 2) + 4 * hi; }
__device__ __forceinline__ f32x16 mm32(const unsigned char* A, int astr, const unsigned char* B, int bstr, int ksteps, int r, int hh) {
    f32x16 acc = {};
    for (int s = 0; s < ksteps; ++s) {
        const bf16x8 a = *(const bf16x8*)(A + r * astr + (16 * s + 8 * hh) * 2);
        const bf16x8 b = *(const bf16x8*)(B + r * bstr + (16 * s + 8 * hh) * 2);
        acc = mfma32(a, b, acc);
    }
    return acc;
}

template <int MODE>
__device__ __forceinline__ void p0_transpose_item(const float* W, int K, int N, bf16* WT, const float* kscale, float* scr, int item, int lane) {
    const int nblk = N / 32, kb = item / nblk, nb = item % nblk, k0 = 64 * kb, n0 = 32 * nb;
#pragma unroll 8
    for (int i = 0; i < 32; ++i) { const int kk = 2 * i + (lane >> 5); float w = W[(size_t)(k0 + kk) * N + n0 + (lane & 31)]; if (kscale) w *= kscale[k0 + kk]; scr[kk * 33 + (lane & 31)] = w; }
    LDS_WAIT(); asm volatile("" ::: "memory");
    const int c = lane & 7;
#pragma unroll
    for (int j = 0; j < 4; ++j) { const int n = (lane >> 3) + 8 * j; const float* s = scr + (8 * c) * 33 + n;
        v4u o; o.x = pk2(s[0 * 33], s[1 * 33]); o.y = pk2(s[2 * 33], s[3 * 33]); o.z = pk2(s[4 * 33], s[5 * 33]); o.w = pk2(s[6 * 33], s[7 * 33]);
        const int gn = n0 + n; const int drow = MODE == 0 ? gn : ((gn >> 2) * 8 + (gn & 3) + (MODE == 2 ? 4 : 0));
        *(v4u*)(WT + (size_t)drow * K + k0 + 8 * c) = o; }
    LDS_WAIT(); asm volatile("" ::: "memory");
}
__device__ __forceinline__ void rms_row_to_bf16(const float* xrow, const float* gain, bf16* orow, int lane) {
    const f32x4* xr = (const f32x4*)xrow + lane; const f32x4* gr = (const f32x4*)gain + lane;
    f32x4 v[4]; float s = 0.f;
#pragma unroll
    for (int j = 0; j < 4; ++j) { v[j] = xr[64 * j]; s += (v[j].x * v[j].x + v[j].y * v[j].y) + (v[j].z * v[j].z + v[j].w * v[j].w); }
    const float rstd = __builtin_amdgcn_rsqf(wave_sum(s) * (1.f / DM) + EPS);
    unsigned long long* o8 = (unsigned long long*)orow + lane;
#pragma unroll
    for (int j = 0; j < 4; ++j) { const f32x4 g = gr[64 * j]; o8[64 * j] = (unsigned long long)pk2(v[j].x * rstd * g.x, v[j].y * rstd * g.y) | ((unsigned long long)pk2(v[j].z * rstd * g.z, v[j].w * rstd * g.w) << 32); }
}
__device__ __forceinline__ void rms_row_inplace(float* xrow, const float* gain, int lane) {
    f32x4* xr = (f32x4*)xrow + lane; const f32x4* gr = (const f32x4*)gain + lane;
    f32x4 v[4]; float s = 0.f;
#pragma unroll
    for (int j = 0; j < 4; ++j) { v[j] = xr[64 * j]; s += (v[j].x * v[j].x + v[j].y * v[j].y) + (v[j].z * v[j].z + v[j].w * v[j].w); }
    const float rstd = __builtin_amdgcn_rsqf(wave_sum(s) * (1.f / DM) + EPS);
#pragma unroll
    for (int j = 0; j < 4; ++j) { const f32x4 g = gr[64 * j]; xr[64 * j] = v[j] * rstd * g; }
}

template <int KDIM>
__device__ __forceinline__ f32x4 mini_tile(const bf16* A, const bf16* Brow, int wave, int lane) {
    const bf16* ap = A + (size_t)(16 * wave + (lane & 15)) * KDIM + 8 * (lane >> 4);
    const bf16* bp = Brow + 8 * (lane >> 4);
    f32x4 acc = {0.f, 0.f, 0.f, 0.f};
#pragma unroll 8
    for (int k0 = 0; k0 < KDIM; k0 += 32) {
        const bf16x8 a = *(const bf16x8*)(ap + k0), b = *(const bf16x8*)(bp + k0);
        acc = __builtin_amdgcn_mfma_f32_16x16x32_bf16(a, b, acc, 0, 0, 0);
    }
    return acc;
}

namespace hg {
constexpr int QT_OFF = 0, KT_OFF = 64 * 272, KTT_OFF = KT_OFF + 64 * 272, VT_OFF = KTT_OFF + 128 * 144, AM_OFF = VT_OFF + 128 * 144, SEG_OFF = AM_OFF + 64 * 144, SCL_OFF = SEG_OFF + 2048;
__device__ __forceinline__ void h1_unit(unsigned char* lds, int u, const bf16* QS, const float* G, const bf16* VR, bf16* QBg, float* KVT, float* DEC, float* OI, int tid, int wave, int lane) {
    const int bh = u >> 7, c = u & 127, b = bh >> 2, h = bh & 3, row0 = b * SEQ + c * CH, colb = h * 128;
    const int col = tid & 127, seg = tid >> 7;
    unsigned char* QT = lds + QT_OFF; unsigned char* KT = lds + KT_OFF; unsigned char* KTT = lds + KTT_OFF; unsigned char* VT = lds + VT_OFF; unsigned char* AM = lds + AM_OFF;
    float* SEG = (float*)(lds + SEG_OFF); float* SCL = (float*)(lds + SCL_OFF);
    float cs[16]; unsigned short qs[16], vv[16];
    { const size_t base = (size_t)(row0 + seg * 16) * 512 + colb + col;
#pragma unroll
      for (int j = 0; j < 16; ++j) { cs[j] = G[base + (size_t)j * 512]; qs[j] = QS[base + (size_t)j * 512]; vv[j] = VR[base + (size_t)j * 512]; } }
    float gk[16];
#pragma unroll
    for (int j = 0; j < 16; ++j) gk[j] = 1.0f - fexp(cs[j]);
#pragma unroll
    for (int j = 1; j < 16; ++j) cs[j] += cs[j - 1];
    SEG[seg * 128 + col] = cs[15];
    __syncthreads();
    const float t0 = SEG[col], t1 = SEG[128 + col], t2 = SEG[256 + col], t3 = SEG[384 + col];
    const float pre = (seg > 0 ? t0 : 0.f) + (seg > 1 ? t1 : 0.f) + (seg > 2 ? t2 : 0.f);
    const float bref = t0 + t1, blast = (t0 + t1) + (t2 + t3);
    if (seg == 0) { DEC[(size_t)u * 128 + col] = fexp(blast); SCL[col] = fexp(blast - bref); }
    unsigned ktp[8], vtp[8];
#pragma unroll
    for (int j = 0; j < 16; j += 2) {
        float kt2[2];
#pragma unroll
        for (int e = 0; e < 2; ++e) { const int jj = j + e; const float bb = cs[jj] + pre, qv = bf2f(qs[jj]);
            const float qt = qv * fexp(bb - bref), kt = gk[jj] * fexp(bref - bb), qb = qv * fexp(bb);
            const int row = seg * 16 + jj;
            *(unsigned short*)(QT + row * 272 + col * 2) = (unsigned short)f2bf(qt);
            *(unsigned short*)(KT + row * 272 + col * 2) = (unsigned short)f2bf(kt);
            QBg[(size_t)(row0 + row) * 512 + colb + col] = (unsigned short)f2bf(qb);
            kt2[e] = kt; }
        ktp[j >> 1] = pk2(kt2[0], kt2[1]); vtp[j >> 1] = (unsigned)vv[j] | ((unsigned)vv[j + 1] << 16);
    }
    *(v4u*)(KTT + col * 144 + seg * 32) = (v4u){ktp[0], ktp[1], ktp[2], ktp[3]}; *(v4u*)(KTT + col * 144 + seg * 32 + 16) = (v4u){ktp[4], ktp[5], ktp[6], ktp[7]};
    *(v4u*)(VT + col * 144 + seg * 32) = (v4u){vtp[0], vtp[1], vtp[2], vtp[3]}; *(v4u*)(VT + col * 144 + seg * 32 + 16) = (v4u){vtp[4], vtp[5], vtp[6], vtp[7]};
    __syncthreads();
    const int r = lane & 31, hh = lane >> 5;
#pragma unroll
    for (int tt = 0; tt < 2; ++tt) { const int vi = wave >> 1, ki = (wave & 1) * 2 + tt;
        const f32x16 acc = mm32(VT + vi * 32 * 144, 144, KTT + ki * 32 * 144, 144, 4, r, hh);
        const int k = ki * 32 + r; const float sc = SCL[k];
#pragma unroll
        for (int i = 0; i < 16; ++i) { const int v = vi * 32 + crow32(i, hh); KVT[((size_t)u * 128 + v) * 128 + k] = acc[i] * sc; } }
    if (wave < 4) { const int ti = wave >> 1, si = wave & 1;
        const f32x16 acc = mm32(QT + ti * 32 * 272, 272, KT + si * 32 * 272, 272, 8, r, hh);
        const int s = si * 32 + r;
#pragma unroll
        for (int i = 0; i < 16; ++i) { const int t = ti * 32 + crow32(i, hh); *(unsigned short*)(AM + t * 144 + s * 2) = (unsigned short)f2bf(s <= t ? acc[i] : 0.f); } }
    __syncthreads();
    { const int ti = wave >> 2, vi = wave & 3;
        const f32x16 acc = mm32(AM + ti * 32 * 144, 144, VT + vi * 32 * 144, 144, 4, r, hh);
        const int v = vi * 32 + r;
#pragma unroll
        for (int i = 0; i < 16; ++i) { const int t = ti * 32 + crow32(i, hh); OI[(size_t)(row0 + t) * 512 + colb + v] = acc[i]; } }
    __syncthreads();
}
__device__ __forceinline__ void h2_scan(int idx, const float* KVT, const float* DEC, bf16* ST, float* sout) {
    const int bh = idx >> 14, vk = idx & 16383, k = idx & 127, v = (idx >> 7) & 127;
    const float* kv = KVT + (size_t)bh * 128 * 16384 + vk; const float* dc = DEC + (size_t)bh * 128 * 128 + k; bf16* st = ST + (size_t)bh * 128 * 16384 + vk;
    float s = 0.f;
    for (int c0 = 0; c0 < NCH; c0 += 8) {
        float a[8], d[8];
#pragma unroll
        for (int j = 0; j < 8; ++j) { a[j] = kv[(size_t)(c0 + j) * 16384]; d[j] = dc[(c0 + j) * 128]; }
#pragma unroll
        for (int j = 0; j < 8; ++j) { st[(size_t)(c0 + j) * 16384] = (unsigned short)f2bf(s); s = d[j] * s + a[j]; }
    }
    sout[((size_t)bh * 128 + k) * 128 + v] = s;
}
constexpr int QBL_OFF = 0, STL_OFF = 64 * 272, RS_OFF = STL_OFF + 128 * 272;
__device__ __forceinline__ void h3_unit(unsigned char* lds, int u, const bf16* QBg, const bf16* ST, const float* OI, const bf16* GS, const float* rgn, bf16* MRG, int tid, int wave, int lane) {
    const int bh = u >> 7, c = u & 127, b = bh >> 2, h = bh & 3, row0 = b * SEQ + c * CH, colb = h * 128;
    unsigned char* QBL = lds + QBL_OFF; unsigned char* STL = lds + STL_OFF; float* RS = (float*)(lds + RS_OFF);
#pragma unroll
    for (int i = 0; i < 2; ++i) { const int q = tid + 512 * i, row = q >> 4, c16 = q & 15;
        *(v4u*)(QBL + row * 272 + c16 * 16) = *(const v4u*)(QBg + (size_t)(row0 + row) * 512 + colb + c16 * 8); }
#pragma unroll
    for (int i = 0; i < 4; ++i) { const int q = tid + 512 * i, v = q >> 4, c16 = q & 15;
        *(v4u*)(STL + v * 272 + c16 * 16) = *(const v4u*)(ST + ((size_t)u * 128 + v) * 128 + c16 * 8); }
    __syncthreads();
    const int r = lane & 31, hh = lane >> 5, ti = wave >> 2, vi = wave & 3, v = vi * 32 + r;
    const f32x16 acc = mm32(QBL + ti * 32 * 272, 272, STL + vi * 32 * 272, 272, 8, r, hh);
    float o[16];
#pragma unroll
    for (int i = 0; i < 16; ++i) { const int t = ti * 32 + crow32(i, hh); o[i] = acc[i] + OI[(size_t)(row0 + t) * 512 + colb + v];
        float ss = o[i] * o[i];
#pragma unroll
        for (int ofs = 1; ofs < 32; ofs <<= 1) ss += __shfl_xor(ss, ofs);
        if (r == 0) RS[t * 4 + vi] = ss; }
    __syncthreads();
    const float gn = rgn[v];
#pragma unroll
    for (int i = 0; i < 16; ++i) { const int t = ti * 32 + crow32(i, hh);
        const f32x4 p = *(const f32x4*)(RS + t * 4); const float rstd = __builtin_amdgcn_rsqf(((p[0] + p[1]) + (p[2] + p[3])) * (1.0f / 128.0f) + EPS);
        const float gs = bf2f(GS[(size_t)(row0 + t) * 512 + colb + v]);
        MRG[(size_t)(row0 + t) * 1024 + colb + v] = (unsigned short)f2bf(o[i] * rstd * gn * gs); }
    __syncthreads();
}
}

namespace dec {
constexpr int WML_OFF = 0, WO_OFF = 1024, LDS_BYTES = WO_OFF + 8 * 2 * 512 * 4;
#ifndef DEC_NT
#define DEC_NT 0
#endif
__device__ __forceinline__ void partial_wave(int unit, const float* cache_k, const float* cache_v, const int* ptab, const float* PSs, float* PARTML, float* PARTO, int lane) {
    const int i = unit >> 4, page = ptab[unit];
    const float* Kp = cache_k + (size_t)page * 65536 + 8 * lane;
    const float* Vp = cache_v + (size_t)page * 65536 + 8 * lane;
    float q[8];
    { const f32x4 q0 = *(const f32x4*)(PSs + (size_t)i * DIN + 2048 + 8 * lane), q1 = *(const f32x4*)(PSs + (size_t)i * DIN + 2048 + 8 * lane + 4);
#pragma unroll
      for (int e = 0; e < 4; ++e) { q[e] = q0[e] * (0.125f * LOG2E); q[4 + e] = q1[e] * (0.125f * LOG2E); } }
#if DEC_NT
#define NTL(p) __builtin_nontemporal_load((const f32x4*)(p))
#else
#define NTL(p) (*(const f32x4*)(p))
#endif
#define DPPF(x, ctrl) __builtin_bit_cast(float, __builtin_amdgcn_update_dpp(0, __builtin_bit_cast(int, (x)), (ctrl), 0xf, 0xf, true))
    const bool hi8 = (lane & 8) != 0;
    float m0 = -1e30f, m1 = -1e30f, l0 = 0.f, l1 = 0.f, o0[8], o1[8];
#pragma unroll
    for (int e = 0; e < 8; ++e) { o0[e] = 0.f; o1[e] = 0.f; }
    f32x4 kA[4][2], vA[4][2], kB[4][2], vB[4][2];
#define LOADG(KX, VX, g) do { _Pragma("unroll") for (int kk = 0; kk < 4; ++kk) { const size_t ro = (size_t)((g) * 4 + kk) * 512; \
        KX[kk][0] = NTL(Kp + ro); KX[kk][1] = NTL(Kp + ro + 4); VX[kk][0] = NTL(Vp + ro); VX[kk][1] = NTL(Vp + ro + 4); } } while (0)
#define PROCG(KX, VX) do { float s0[4], s1[4]; \
        _Pragma("unroll") for (int kk = 0; kk < 4; ++kk) { \
            float d = (KX[kk][0][0] * q[0] + KX[kk][0][1] * q[1]) + (KX[kk][0][2] * q[2] + KX[kk][0][3] * q[3]) + (KX[kk][1][0] * q[4] + KX[kk][1][1] * q[5]) + (KX[kk][1][2] * q[6] + KX[kk][1][3] * q[7]); \
            d += DPPF(d, 0xB1); d += DPPF(d, 0x4E); d += DPPF(d, 0x141); const float e_ = DPPF(d, 0x128); s0[kk] = hi8 ? e_ : d; s1[kk] = hi8 ? d : e_; } \
        const float n0 = fmaxf(fmaxf(fmaxf(s0[0], s0[1]), fmaxf(s0[2], s0[3])), m0), n1 = fmaxf(fmaxf(fmaxf(s1[0], s1[1]), fmaxf(s1[2], s1[3])), m1); \
        const float a0 = __builtin_amdgcn_exp2f(m0 - n0), a1 = __builtin_amdgcn_exp2f(m1 - n1); m0 = n0; m1 = n1; \
        float ps0 = 0.f, ps1 = 0.f; \
        _Pragma("unroll") for (int kk = 0; kk < 4; ++kk) { s0[kk] = __builtin_amdgcn_exp2f(s0[kk] - n0); s1[kk] = __builtin_amdgcn_exp2f(s1[kk] - n1); ps0 += s0[kk]; ps1 += s1[kk]; } \
        l0 = l0 * a0 + ps0; l1 = l1 * a1 + ps1; \
        _Pragma("unroll") for (int e = 0; e < 4; ++e) { \
            o0[e] = o0[e] * a0 + ((s0[0] * VX[0][0][e] + s0[1] * VX[1][0][e]) + (s0[2] * VX[2][0][e] + s0[3] * VX[3][0][e])); \
            o0[4 + e] = o0[4 + e] * a0 + ((s0[0] * VX[0][1][e] + s0[1] * VX[1][1][e]) + (s0[2] * VX[2][1][e] + s0[3] * VX[3][1][e])); \
            o1[e] = o1[e] * a1 + ((s1[0] * VX[0][0][e] + s1[1] * VX[1][0][e]) + (s1[2] * VX[2][0][e] + s1[3] * VX[3][0][e])); \
            o1[4 + e] = o1[4 + e] * a1 + ((s1[0] * VX[0][1][e] + s1[1] * VX[1][1][e]) + (s1[2] * VX[2][1][e] + s1[3] * VX[3][1][e])); } } while (0)
    LOADG(kA, vA, 0);
    for (int g = 0; g < 32; g += 2) {
        LOADG(kB, vB, g + 1);
        PROCG(kA, vA);
        if (g + 2 < 32) LOADG(kA, vA, g + 2);
        PROCG(kB, vB);
    }
#undef LOADG
#undef PROCG
#undef NTL
#undef DPPF
    if ((lane & 7) == 0) { const int hm = lane >> 3; PARTML[((size_t)unit * 8 + hm) * 2] = hi8 ? m1 : m0; PARTML[((size_t)unit * 8 + hm) * 2 + 1] = hi8 ? l1 : l0; }
    { float* w0 = PARTO + ((size_t)unit * 2 + 0) * 512 + 8 * lane; float* w1 = PARTO + ((size_t)unit * 2 + 1) * 512 + 8 * lane;
      *(f32x4*)w0 = (f32x4){o0[0], o0[1], o0[2], o0[3]}; *(f32x4*)(w0 + 4) = (f32x4){o0[4], o0[5], o0[6], o0[7]};
      *(f32x4*)w1 = (f32x4){o1[0], o1[1], o1[2], o1[3]}; *(f32x4*)(w1 + 4) = (f32x4){o1[4], o1[5], o1[6], o1[7]}; }
}
__device__ __forceinline__ void combine_item(unsigned char* lds, int i, const float* PSs, const float* PARTML, const float* PARTO, const float* subln, float lam, bf16* MRGs, int tid, int wave, int lane) {
    float* CW = (float*)lds;
    float* SSQ = (float*)(lds + 1024);
    { const int hm = wave;
      const float qv = PSs[(size_t)i * DIN + 2048 + hm * 64 + lane] * (0.125f * LOG2E), kn = PSs[(size_t)i * DIN + 2560 + hm * 64 + lane];
      const float sn = wave_sum(qv * kn);
      float Mj = -1e30f, Lj = 0.f;
      if (lane < 16) { Mj = PARTML[(((size_t)i * 16 + lane) * 8 + hm) * 2]; Lj = PARTML[(((size_t)i * 16 + lane) * 8 + hm) * 2 + 1]; }
      const float M = fmaxf(wave_max(Mj), sn);
      const float wj = (lane < 16) ? __builtin_amdgcn_exp2f(Mj - M) : 0.f, wn = __builtin_amdgcn_exp2f(sn - M);
      const float Lt = wave_sum(wj * Lj) + wn, inv = 1.0f / Lt;
      if (lane < 16) CW[hm * 17 + lane] = wj * inv;
      if (lane == 16) CW[hm * 17 + 16] = wn * inv; }
    __syncthreads();
    const int h = tid >> 7;
    float om[2];
#pragma unroll
    for (int m = 0; m < 2; ++m) { const int hm = 2 * h + m; float a = CW[hm * 17 + 16] * PSs[(size_t)i * DIN + 3072 + tid];
#pragma unroll
        for (int j = 0; j < 16; ++j) a += CW[hm * 17 + j] * PARTO[(((size_t)i * 16 + j) * 2 + m) * 512 + tid];
        om[m] = a; }
    const float a = om[0] - lam * om[1];
    const float ssw = wave_sum(a * a);
    if (lane == 0) SSQ[wave] = ssw;
    __syncthreads();
    const float ss = SSQ[2 * h] + SSQ[2 * h + 1];
    const float rstd = __builtin_amdgcn_rsqf(ss * (1.0f / 128.0f) + EPS);
    MRGs[(size_t)i * 1024 + 512 + tid] = (unsigned short)f2bf(a * rstd * subln[tid & 127] * (1.0f - LAM_INIT));
    __syncthreads();
}
__device__ __forceinline__ void recurrent_unit(unsigned char* lds, int unit, const float* PSs, const float* state, const float* lbp, const float* rgn, float* sout, bf16* MRGs, int tid, int wave, int lane) {
    const int i = unit >> 2, h = unit & 3;
    float* RO = (float*)lds;
    float* SSQ = (float*)(lds + 8192);
    const int v4 = (tid & 31) * 4, ks = tid >> 5;
    const float* ps = PSs + (size_t)i * DIN;
    const f32x4 vv = *(const f32x4*)(ps + 1024 + h * 128 + v4);
    const float* sp = state + ((size_t)unit * 128) * 128 + v4; float* so = sout + ((size_t)unit * 128) * 128 + v4;
    f32x4 po = {0.f, 0.f, 0.f, 0.f};
    f32x4 sold[8];
#pragma unroll
    for (int jj = 0; jj < 8; ++jj) sold[jj] = *(const f32x4*)(sp + (size_t)(ks + 16 * jj) * 128);
#pragma unroll
    for (int jj = 0; jj < 8; ++jj) { const int k = ks + 16 * jj, kc = h * 128 + k;
        const float lb = sigm(lbp[kc] - lbp[512 + kc]); const float f = lb + (1.0f - lb) * sigm(ps[512 + kc]); const float kk = 1.0f - f, qk = siluf(ps[kc]);
        const f32x4 sn = sold[jj] * f + vv * kk; *(f32x4*)(so + (size_t)k * 128) = sn; po += sn * qk; }
    *(f32x4*)(RO + ks * 128 + v4) = po;
    __syncthreads();
    float o = 0.f;
    if (tid < 128) {
#pragma unroll
        for (int j = 0; j < 16; ++j) o += RO[j * 128 + tid];
        const float ssw = wave_sum(o * o); if (lane == 0) SSQ[wave] = ssw; }
    __syncthreads();
    if (tid < 128) { const float rstd = __builtin_amdgcn_rsqf((SSQ[0] + SSQ[1]) * (1.0f / 128.0f) + EPS);
        MRGs[(size_t)i * 1024 + h * 128 + tid] = (unsigned short)f2bf(o * rstd * rgn[tid] * siluf(ps[1536 + h * 128 + tid])); }
    __syncthreads();
}
}
#ifndef MK_N_LAUNCHES
#define MK_N_LAUNCHES 1
#endif
constexpr int N_PHASES = 9;
constexpr int N_LAUNCHES = MK_N_LAUNCHES;
static_assert(N_LAUNCHES == 1 || N_LAUNCHES == N_PHASES, "MK_N_LAUNCHES is 1 or 9");
constexpr size_t MiB = 1u << 20;
constexpr size_t WS_CTL = 0, CTL_ZERO_BYTES = 1 * MiB;
constexpr size_t WS_WIN = 2 * MiB;
constexpr size_t WS_WOUT = 10 * MiB;
constexpr size_t WS_WGU = 12 * MiB;
constexpr size_t WS_WD = 24 * MiB;
constexpr size_t WS_PSS = 30 * MiB;
constexpr size_t WS_PS1 = 32 * MiB;
constexpr size_t WS_PS1S = 33 * MiB;
constexpr size_t WS_DEC = 34 * MiB;
constexpr size_t WS_PML = 35 * MiB;
constexpr size_t WS_PO = 36 * MiB;
constexpr size_t WS_XN = 48 * MiB;
constexpr size_t WS_QS = 96 * MiB, WS_VR = 112 * MiB, WS_GS = 128 * MiB, WS_QA = 144 * MiB, WS_KA = 160 * MiB, WS_VA = 176 * MiB;
constexpr size_t WS_G = 192 * MiB;
constexpr size_t WS_QB = 224 * MiB;
constexpr size_t WS_OI = 240 * MiB;
constexpr size_t WS_KVT = 272 * MiB;
constexpr size_t WS_ST = 336 * MiB;
constexpr size_t WS_MRG = 368 * MiB;
constexpr size_t WS_X1 = 416 * MiB;
constexpr size_t WS_XB = 496 * MiB;
constexpr size_t WS_H = 544 * MiB;
constexpr size_t WS_END = 640 * MiB;
constexpr int CW_TMO = 0, CW_BAR = 4096;
constexpr size_t O_Y = 0, O_YS = (size_t)MP * DM, O_KP = O_YS + (size_t)MS * DM, O_VP = O_KP + (size_t)MP * 512, O_SP = O_VP + (size_t)MP * 512,
                 O_KS = O_SP + 8 * 16384, O_VS = O_KS + (size_t)MS * 512, O_SS = O_VS + (size_t)MS * 512, O_END = O_SS + (size_t)MS * 4 * 16384;
constexpr int RING_OFF = 0, RING_BYTES = 143360;
constexpr int LDSCTL_OFF = RING_BYTES, MISC_OFF = LDSCTL_OFF + 320;
constexpr int LDS_BYTES = 147456;
static_assert(att::LDS_BYTES <= RING_BYTES && MISC_OFF + 128 <= LDS_BYTES, "LDS map");

struct Args { const float* in[21]; const int* ptab; float* out; unsigned char* ws; int ph_lo, ph_hi; };

__global__ void __launch_bounds__(NWAVES * 64, 2) mk_fwd(Args args) {
    extern __shared__ __attribute__((aligned(16))) unsigned char lds[];
    const int tid = threadIdx.x, lane = tid & 63, wave = __builtin_amdgcn_readfirstlane(tid >> 6);
    const int G = gridDim.x, bx = blockIdx.x;
    volatile LAS unsigned* MISC = (volatile LAS unsigned*)((LAS unsigned char*)lds + MISC_OFF);
    unsigned char* ws = args.ws;
    gu32* ctl = (gu32*)(ws + WS_CTL);
    for (int u = tid; u < (LDS_BYTES - LDSCTL_OFF) / 4; u += NWAVES * 64) ((LAS unsigned*)((LAS unsigned char*)lds + LDSCTL_OFF))[u] = 0u;
    __syncthreads();
    XcdBarrier bar; bar.bar = (unsigned*)(ctl + CW_BAR); bar.x = 0; bar.st = nullptr;
    if (N_LAUNCHES == 1) bar = xcd_barrier_post((unsigned*)(ctl + CW_BAR), MISC + 8);
#ifndef BAR_REPS
#define BAR_REPS 1
#endif
#define GRID_BAR() do { if (N_LAUNCHES == 1) { for (int br_ = 0; br_ < BAR_REPS; ++br_) xcd_barrier(bar); } } while (0)
    const int lo = args.ph_lo, hi = args.ph_hi;
#ifndef PHASE_MASK
#define PHASE_MASK 0x1ff
#endif
#define IN(k) (((PHASE_MASK >> (k)) & 1) && lo <= (k) && (k) < hi)
#define BOTH(k) (IN(k) && IN((k) + 1))
#ifndef DBL_MASK
#define DBL_MASK 0
#endif
#define NREP(k) (((DBL_MASK >> (k)) & 1) ? 2 : 1)
    const float* x_p = args.in[0]; const float* x_s = args.in[1]; const float* cache_k = args.in[2]; const float* cache_v = args.in[3]; const float* state = args.in[4];
    const float* w_in = args.in[6]; const float* w_out = args.in[7]; const float* lbp = args.in[8]; const float* rgn = args.in[9];
    const float* lq1 = args.in[10]; const float* lk1 = args.in[11]; const float* lq2 = args.in[12]; const float* lk2 = args.in[13]; const float* subln = args.in[14];
    const float* n_mix = args.in[15]; const float* n_ffn = args.in[16]; const float* w_gate = args.in[17]; const float* w_up = args.in[18]; const float* w_down = args.in[19]; const float* n_fin = args.in[20];
    const int* ptab = args.ptab; float* out = args.out;
    bf16* Win_t = (bf16*)(ws + WS_WIN); bf16* Wout_t = (bf16*)(ws + WS_WOUT); bf16* Wgu_t = (bf16*)(ws + WS_WGU); bf16* Wd_t = (bf16*)(ws + WS_WD);
    float* PSs = (float*)(ws + WS_PSS); float* PS1 = (float*)(ws + WS_PS1); float* PS1s = (float*)(ws + WS_PS1S); float* DEC = (float*)(ws + WS_DEC);
    float* PML = (float*)(ws + WS_PML); float* PO = (float*)(ws + WS_PO);
    bf16* XN = (bf16*)(ws + WS_XN); bf16* QS = (bf16*)(ws + WS_QS); bf16* VR = (bf16*)(ws + WS_VR); bf16* GS = (bf16*)(ws + WS_GS);
    bf16* QA = (bf16*)(ws + WS_QA); bf16* KA = (bf16*)(ws + WS_KA); bf16* VA = (bf16*)(ws + WS_VA); float* Gl = (float*)(ws + WS_G);
    bf16* QBg = (bf16*)(ws + WS_QB); float* OI = (float*)(ws + WS_OI); float* KVT = (float*)(ws + WS_KVT); bf16* ST = (bf16*)(ws + WS_ST);
    bf16* MRG = (bf16*)(ws + WS_MRG); float* X1 = (float*)(ws + WS_X1); bf16* XB = (bf16*)(ws + WS_XB); bf16* Hb = (bf16*)(ws + WS_H);

    if (IN(0)) { _Pragma("unroll") for (int rep = 0; rep < NREP(0); ++rep) {
        float* scr = (float*)(lds + RING_OFF + wave * 16384);
        const int gw = bx * NWAVES + wave, NGW = G * NWAVES;
        constexpr int I_IN = (DM / 64) * (DIN / 32), I_OUT = (DM / 64) * (DM / 32), I_G = (DM / 64) * (DFF / 32), I_D = (DFF / 64) * (DM / 32);
        constexpr int NITEMS = I_IN + I_OUT + 2 * I_G + I_D;
        for (int it = gw; it < NITEMS; it += NGW) {
            int r = it;
            if (r < I_IN) { p0_transpose_item<0>(w_in, DM, DIN, Win_t, nullptr, scr, r, lane); continue; } r -= I_IN;
            if (r < I_OUT) { p0_transpose_item<0>(w_out, DM, DM, Wout_t, nullptr, scr, r, lane); continue; } r -= I_OUT;
            if (r < I_G) { p0_transpose_item<1>(w_gate, DM, DFF, Wgu_t, n_ffn, scr, r, lane); continue; } r -= I_G;
            if (r < I_G) { p0_transpose_item<2>(w_up, DM, DFF, Wgu_t, n_ffn, scr, r, lane); continue; } r -= I_G;
            p0_transpose_item<0>(w_down, DFF, DM, Wd_t, nullptr, scr, r, lane);
        }
        for (int m = gw; m < MT; m += NGW) rms_row_to_bf16(m < MP ? x_p + (size_t)m * DM : x_s + (size_t)(m - MP) * DM, n_mix, XN + (size_t)m * DM, lane);
        __syncthreads(); }
        if (BOTH(0)) GRID_BAR();
    }
    if (IN(1)) { _Pragma("unroll") for (int rep = 0; rep < NREP(1); ++rep) {
        { pg8::Gemm g{XN, Win_t, MP, DIN, DM}; pg8::StaticOrder S; S.init(MP, DIN, G, bx);
          pg8::EpiInProj E{QS, VR, GS, QA, KA, VA, Gl, out + O_KP, out + O_VP, lbp};
          pg8::gemm_phase<pg8::EpiInProj, pg8::StaticOrder, true, true>((LAS unsigned char*)lds + RING_OFF, g, S, E); }
        if (bx >= G / 2) {
            for (int t = bx - G / 2; t < DIN / 16; t += G / 2) { const int n0 = t * 16;
                const f32x4 acc = mini_tile<DM>(XN + (size_t)MP * DM, Win_t + (size_t)(n0 + (lane & 15)) * DM, wave, lane);
                const int c = lane & 15, q = lane >> 4;
#pragma unroll
                for (int i = 0; i < 4; ++i) { const int row = 16 * wave + 4 * q + i; const float v = acc[i];
                    PSs[(size_t)row * DIN + n0 + c] = v;
                    if (n0 >= 2560 && n0 < 3072) out[O_KS + (size_t)row * 512 + (n0 - 2560) + c] = v;
                    if (n0 >= 3072) out[O_VS + (size_t)row * 512 + (n0 - 3072) + c] = v; } }
        } }
        if (BOTH(1)) GRID_BAR();
    }
    if (IN(2)) {
        for (int rep = 0; rep < NREP(9); ++rep) for (int u = bx; u < NHU; u += G) hg::h1_unit(lds + RING_OFF, u, QS, Gl, VR, QBg, KVT, DEC, OI, tid, wave, lane);
        __syncthreads();
        { att::Consts C; const float s1 = wave_sum(lq1[lane] * lk1[lane]), s2 = wave_sum(lq2[lane] * lk2[lane]);
          C.lam = __builtin_bit_cast(float, __builtin_amdgcn_readfirstlane(__builtin_bit_cast(int, fexp(s1) - fexp(s2) + LAM_INIT))); C.oscale = 1.0f - LAM_INIT; C.subln = subln;
          if ((bx & 7) < 4) { for (int rep = 0; rep < NREP(11); ++rep) for (int u = bx * NWAVES + wave; u < MS * NPAGES; u += G * NWAVES) dec::partial_wave(u, cache_k, cache_v, ptab, PSs, PML, PO, lane); }
          att::attn_phase((char*)lds + RING_OFF, QA, KA, VA, MRG, C, G, bx);
          if ((bx & 7) >= 4) { for (int rep = 0; rep < NREP(11); ++rep) for (int u = bx * NWAVES + wave; u < MS * NPAGES; u += G * NWAVES) dec::partial_wave(u, cache_k, cache_v, ptab, PSs, PML, PO, lane); } }
        if (BOTH(2)) GRID_BAR();
    }
    if (IN(3)) { _Pragma("unroll") for (int rep = 0; rep < NREP(3); ++rep) {
        for (int idx = bx * 512 + tid; idx < 8 * 16384; idx += G * 512) hg::h2_scan(idx, KVT, DEC, ST, out + O_SP);
        { const float s1 = wave_sum(lq1[lane] * lk1[lane]), s2 = wave_sum(lq2[lane] * lk2[lane]); const float lam = fexp(s1) - fexp(s2) + LAM_INIT;
          for (int i = bx; i < MS; i += G) dec::combine_item(lds + RING_OFF, i, PSs, PML, PO, subln, lam, MRG + (size_t)MP * DM, tid, wave, lane); }
        for (int u = bx; u < MS * 4; u += G) dec::recurrent_unit(lds + RING_OFF, u, PSs, state, lbp, rgn, out + O_SS, MRG + (size_t)MP * DM, tid, wave, lane); }
        if (BOTH(3)) GRID_BAR();
    }
    if (IN(4)) {
        for (int rep = 0; rep < NREP(4); ++rep) for (int u = bx; u < NHU; u += G) hg::h3_unit(lds + RING_OFF, u, QBg, ST, OI, GS, rgn, MRG, tid, wave, lane);
        if (BOTH(4)) GRID_BAR();
    }
    if (IN(5)) { _Pragma("unroll") for (int rep = 0; rep < NREP(5); ++rep) {
        { pg8::Gemm g{MRG, Wout_t, MP, DM, DM}; pg8::StaticOrder S; S.init(MP, DM, G, bx);
          pg8::EpiWout E{x_p, X1, XB, PS1};
          pg8::gemm_phase<pg8::EpiWout, pg8::StaticOrder, true, true>((LAS unsigned char*)lds + RING_OFF, g, S, E); }
        for (int t = bx; t < DM / 16; t += G) { const int n0 = t * 16;
            const f32x4 acc = mini_tile<DM>(MRG + (size_t)MP * DM, Wout_t + (size_t)(n0 + (lane & 15)) * DM, wave, lane);
            const int c = lane & 15, q = lane >> 4;
#pragma unroll
            for (int i = 0; i < 4; ++i) { const int row = 16 * wave + 4 * q + i; const float v = x_s[(size_t)row * DM + n0 + c] + acc[i];
                X1[(size_t)(MP + row) * DM + n0 + c] = v; XB[(size_t)(MP + row) * DM + n0 + c] = (unsigned short)f2bf(v);
                float ss = v * v; ss += __shfl_xor(ss, 1); ss += __shfl_xor(ss, 2); ss += __shfl_xor(ss, 4); ss += __shfl_xor(ss, 8);
                if (c == 0) PS1s[row * 64 + t] = ss; } } }
        if (BOTH(5)) GRID_BAR();
    }
    if (IN(6)) { _Pragma("unroll") for (int rep = 0; rep < NREP(6); ++rep) {
        { pg8::Gemm g{XB, Wgu_t, MP, NGU, DM}; pg8::StaticOrder S; S.init(MP, NGU, G, bx);
          pg8::EpiGateUp E{PS1, Hb};
          pg8::gemm_phase<pg8::EpiGateUp, pg8::StaticOrder, true, true>((LAS unsigned char*)lds + RING_OFF, g, S, E); }
        if (bx >= G / 2) {
            float* RSTD = (float*)(lds + RING_OFF);
            if (tid < MS) { float s = 0.f;
#pragma unroll
                for (int j = 0; j < 16; ++j) { const f32x4 p = *(const f32x4*)(PS1s + tid * 64 + 4 * j); s += (p[0] + p[1]) + (p[2] + p[3]); }
                RSTD[tid] = __builtin_amdgcn_rsqf(s * (1.0f / 1024.0f) + EPS); }
            __syncthreads();
            for (int t = bx - G / 2; t < DFF / 16; t += G / 2) { const int f0 = t * 16, f = f0 + (lane & 15), grow = (f >> 2) * 8 + (f & 3);
                const f32x4 ag = mini_tile<DM>(XB + (size_t)MP * DM, Wgu_t + (size_t)grow * DM, wave, lane);
                const f32x4 au = mini_tile<DM>(XB + (size_t)MP * DM, Wgu_t + (size_t)(grow + 4) * DM, wave, lane);
                const int c = lane & 15, q = lane >> 4;
#pragma unroll
                for (int i = 0; i < 4; ++i) { const int row = 16 * wave + 4 * q + i; const float rs = RSTD[row];
                    Hb[(size_t)(MP + row) * DFF + f0 + c] = (unsigned short)f2bf(siluf(ag[i] * rs) * (au[i] * rs)); } }
            __syncthreads();
        } }
        if (BOTH(6)) GRID_BAR();
    }
    if (IN(7)) { _Pragma("unroll") for (int rep = 0; rep < NREP(7); ++rep) {
        { pg8::Gemm g{Hb, Wd_t, MP, DM, DFF}; pg8::StaticOrder S; S.init(MP, DM, G, bx);
          pg8::EpiDown E{X1, out + O_Y};
          pg8::gemm_phase<pg8::EpiDown, pg8::StaticOrder, true, true>((LAS unsigned char*)lds + RING_OFF, g, S, E); }
        for (int t = bx; t < DM / 16; t += G) { const int n0 = t * 16;
            const f32x4 acc = mini_tile<DFF>(Hb + (size_t)MP * DFF, Wd_t + (size_t)(n0 + (lane & 15)) * DFF, wave, lane);
            const int c = lane & 15, q = lane >> 4;
#pragma unroll
            for (int i = 0; i < 4; ++i) { const int row = 16 * wave + 4 * q + i;
                out[O_YS + (size_t)row * DM + n0 + c] = X1[(size_t)(MP + row) * DM + n0 + c] + acc[i]; } } }
        if (BOTH(7)) GRID_BAR();
    }
    if (IN(8)) {
        const int gw = bx * NWAVES + wave, NGW = G * NWAVES;
        for (int m = gw; m < MT; m += NGW) rms_row_inplace(m < MP ? out + O_Y + (size_t)m * DM : out + O_YS + (size_t)(m - MP) * DM, n_fin, lane);
    }
#undef IN
#undef BOTH
#undef GRID_BAR
}

extern "C" void kernel_launch(void* const* d_in, const int* in_sizes, int n_in, void* d_out, int out_size, void* d_ws, size_t ws_size, hipStream_t stream) {
    static int grid = 0;
    if (grid == 0) {
        if (n_in != 21 || in_sizes[0] != MP * DM || (size_t)out_size != O_END || ws_size < WS_END) {
            fprintf(stderr, "kernel_launch: unexpected shapes (n_in %d, in0 %d, out %d, ws %zu); nothing launched\n", n_in, n_in > 0 ? in_sizes[0] : -1, out_size, ws_size); grid = -1; return; }
        int dev = 0, cus = 0, per_cu = 0;
        if (hipGetDevice(&dev) != hipSuccess || hipDeviceGetAttribute(&cus, hipDeviceAttributeMultiprocessorCount, dev) != hipSuccess) { grid = -1; return; }
        if (hipFuncSetAttribute((const void*)mk_fwd, hipFuncAttributeMaxDynamicSharedMemorySize, LDS_BYTES) != hipSuccess) { fprintf(stderr, "kernel_launch: hipFuncSetAttribute failed\n"); grid = -1; return; }
        if (hipOccupancyMaxActiveBlocksPerMultiprocessor(&per_cu, (const void*)mk_fwd, NWAVES * 64, LDS_BYTES) != hipSuccess || per_cu < 1)
            fprintf(stderr, "kernel_launch: note: occupancy query reports %d workgroups per CU\n", per_cu);
        (void)hipGetLastError();
        grid = cus;
        if (grid > 256) grid = 256;
        grid &= ~7;
    }
    if (grid <= 0) return;
    (void)hipMemsetAsync((char*)d_ws + WS_CTL, 0, CTL_ZERO_BYTES, stream);
    Args a{};
    for (int i = 0; i < 21; ++i) a.in[i] = (const float*)d_in[i];
    a.ptab = (const int*)d_in[5]; a.out = (float*)d_out; a.ws = (unsigned char*)d_ws;
    if (N_LAUNCHES == 1) { a.ph_lo = 0; a.ph_hi = N_PHASES; hipLaunchKernelGGL(mk_fwd, dim3(grid), dim3(NWAVES * 64), LDS_BYTES, stream, a); }
    else for (int p = 0; p < N_PHASES; ++p) { a.ph_lo = p; a.ph_hi = p + 1; hipLaunchKernelGGL(mk_fwd, dim3(grid), dim3(NWAVES * 64), LDS_BYTES, stream, a); }
    const hipError_t le = hipPeekAtLastError();
    if (le != hipSuccess) fprintf(stderr, "kernel_launch: launch failed: %s\n", hipGetErrorName(le));
}
```
